# Optimizing an MI355X kernel written in HIP

```python
import jax, jax.numpy as jnp
from jax import lax
import numpy as np

D_MODEL = 2048
BATCH = 4
SEQ = 4096
DEPTH = 4

D_FF = 5632
POOL_WINDOWS = (2, 4, 8, 16)
N_POOL_GROUPS = len(POOL_WINDOWS)
POOL_WIDTH = 1024
POOL_GROUP_DIM = POOL_WIDTH // N_POOL_GROUPS
SGU_HEADS = 8
SGU_HEAD_DIM = 128
SGU_WIDTH = SGU_HEADS * SGU_HEAD_DIM
CHUNK = 128
IN_PROJ_WIDTH = POOL_WIDTH + 2 * SGU_WIDTH + 2 * D_MODEL
MACARON_WEIGHT = 0.5
EPS = 1e-6

kernel_name = "hybrid_pool_sgu_macaron_block"


def rmsnorm(x, g):
    xf = x.astype(jnp.float32)
    var = jnp.mean(xf * xf, axis=-1, keepdims=True)
    return (xf * lax.rsqrt(var + EPS)).astype(x.dtype) * g


def swiglu(h, w_up, w_down):
    gate, up = jnp.split(h @ w_up, 2, axis=-1)
    return (jax.nn.silu(gate) * up) @ w_down


def pool_mixer(p, w_group, scale):
    B, S, _ = p.shape
    maxw = POOL_WINDOWS[-1]
    pf = p.astype(jnp.float32)
    cs = jnp.cumsum(pf, axis=1)
    cs_pad = jnp.pad(cs, ((0, 0), (maxw, 0), (0, 0)))
    pos = jnp.arange(1, S + 1, dtype=jnp.int32)
    outs = []
    for g, w in enumerate(POOL_WINDOWS):
        sl = slice(g * POOL_GROUP_DIM, (g + 1) * POOL_GROUP_DIM)
        prev = cs_pad[:, maxw - w: maxw - w + S, sl]
        cnt = jnp.minimum(pos, w).astype(jnp.float32)[None, :, None]
        outs.append((cs[:, :, sl] - prev) / cnt - pf[:, :, sl])
    d = jnp.stack(outs, axis=2).astype(p.dtype)
    y = jnp.einsum('bsgc,gcd->bsgd', d, w_group)
    return y.reshape(B, S, POOL_WIDTH) * scale


def spatial_gating(u, v, v_gain, w_s, b_s):
    B, S, _ = u.shape
    n_chunks = S // CHUNK
    v = rmsnorm(v, v_gain)
    vc = v.reshape(B, n_chunks, CHUNK, SGU_HEADS, SGU_HEAD_DIM)
    w = w_s * jnp.tril(jnp.ones((CHUNK, CHUNK), dtype=w_s.dtype))
    s = jnp.einsum('hts,bnshc->bnthc', w, vc) + b_s.T[None, None, :, :, None]
    return u * s.reshape(B, S, SGU_WIDTH)


def setup_inputs(seed: int = 0) -> dict:
    key = jax.random.key(seed)
    ks = jax.random.split(key, 32)
    L, D = DEPTH, D_MODEL

    def dense(k, shape, fan_in):
        return jax.random.normal(k, shape, jnp.float32) * (fan_in ** -0.5)

    def gain(k, shape):
        return 1.0 + 0.05 * jax.random.normal(k, shape, jnp.float32)

    return {
        "x": jax.random.normal(ks[0], (BATCH, SEQ, D), jnp.float32),
        "g_ffn1_pre": gain(ks[1], (L, D)),
        "w_ffn1_up": dense(ks[2], (L, D, 2 * D_FF), D),
        "w_ffn1_down": dense(ks[3], (L, D_FF, D), D_FF),
        "g_ffn1_post": gain(ks[4], (L, D)),
        "g_mix_pre": gain(ks[5], (L, D)),
        "w_in": dense(ks[6], (L, D, IN_PROJ_WIDTH), D),
        "pool_group_w": dense(ks[7], (L, N_POOL_GROUPS, POOL_GROUP_DIM, POOL_GROUP_DIM), POOL_GROUP_DIM),
        "pool_scale": gain(ks[8], (L, POOL_WIDTH)),
        "w_pool_out": dense(ks[9], (L, POOL_WIDTH, D), POOL_WIDTH),
        "sgu_v_gain": gain(ks[10], (L, SGU_WIDTH)),
        "sgu_w_s": dense(ks[11], (L, SGU_HEADS, CHUNK, CHUNK), CHUNK),
        "sgu_b_s": gain(ks[12], (L, SGU_HEADS, CHUNK)),
        "w_sgu_out": dense(ks[13], (L, SGU_WIDTH, D), SGU_WIDTH),
        "w_out": dense(ks[14], (L, D, D), D),
        "g_mix_post": gain(ks[15], (L, D)),
        "g_ffn2_pre": gain(ks[16], (L, D)),
        "w_ffn2_up": dense(ks[17], (L, D, 2 * D_FF), D),
        "w_ffn2_down": dense(ks[18], (L, D_FF, D), D_FF),
        "g_ffn2_post": gain(ks[19], (L, D)),
    }


def reference(x, g_ffn1_pre, w_ffn1_up, w_ffn1_down, g_ffn1_post, g_mix_pre, w_in,
              pool_group_w, pool_scale, w_pool_out, sgu_v_gain, sgu_w_s, sgu_b_s,
              w_sgu_out, w_out, g_mix_post, g_ffn2_pre, w_ffn2_up, w_ffn2_down, g_ffn2_post):
    splits = (POOL_WIDTH, POOL_WIDTH + SGU_WIDTH, POOL_WIDTH + 2 * SGU_WIDTH,
              POOL_WIDTH + 2 * SGU_WIDTH + D_MODEL)
    for i in range(DEPTH):
        f = swiglu(rmsnorm(x, g_ffn1_pre[i]), w_ffn1_up[i], w_ffn1_down[i])
        x = x + MACARON_WEIGHT * rmsnorm(f, g_ffn1_post[i])

        h = rmsnorm(x, g_mix_pre[i])
        p, u, v, ga, gb = jnp.split(h @ w_in[i], splits, axis=-1)
        y_a = pool_mixer(p, pool_group_w[i], pool_scale[i]) @ w_pool_out[i]
        y_b = spatial_gating(jax.nn.gelu(u), jax.nn.gelu(v), sgu_v_gain[i],
                             sgu_w_s[i], sgu_b_s[i]) @ w_sgu_out[i]
        m = jax.nn.sigmoid(ga) * y_a + jax.nn.sigmoid(gb) * y_b
        x = x + rmsnorm(m @ w_out[i], g_mix_post[i])

        f = swiglu(rmsnorm(x, g_ffn2_pre[i]), w_ffn2_up[i], w_ffn2_down[i])
        x = x + MACARON_WEIGHT * rmsnorm(f, g_ffn2_post[i])
    return x
```

```cpp
#include <hip/hip_runtime.h>
#include <cstdio>
#include <cstdint>

#ifndef MK_ONE_LAUNCH
#define MK_ONE_LAUNCH 1
#endif

namespace pg8 {
#define PG8_LAS __attribute__((address_space(3)))
typedef unsigned short bf16_t;
typedef short bf16x8 __attribute__((ext_vector_type(8)));
typedef float f32x4 __attribute__((ext_vector_type(4)));
typedef float f32x2 __attribute__((ext_vector_type(2)));
typedef unsigned u32x4 __attribute__((ext_vector_type(4)));
typedef unsigned u32x2 __attribute__((ext_vector_type(2)));
constexpr int BM = 256, BK = 64, HALF = 128, HTB = HALF * BK * 2  , STAGE_BYTES = 8 * HTB, NXCD = 8, WGM = 8;

__host__ __device__ __forceinline__ int lds_byte(int r, int c) { const int st = (r >> 4) * 2 + (c >> 5), rr = r & 15, cc = c & 31, ob = rr * 64 + cc * 2; return st * 1024 + (ob ^ (((ob >> 9) & 1) << 5)); }
__host__ __device__ __forceinline__ void stage_rc(int b, int& R, int& C) { const int st = b / 1024, sb = b % 1024, swz = sb ^ (((sb >> 9) & 1) << 5); R = (st >> 1) * 16 + swz / 64; C = (st & 1) * 32 + (swz % 64) / 2; }
__host__ __device__ __forceinline__ int perm32(int rho) { const int n = rho >> 4, i = rho & 15; return 8 * (i >> 2) + 4 * n + (i & 3); }

struct Unit { int pm, pn; };
struct Gemm { const bf16_t* A; const bf16_t* Bt; int M, N, K, lda, ldb, a_pn_koff; };

struct StaticOrder {
    int nM, nN, nwg, G, c;
    __host__ __device__ void init(int M, int N, int G_, int c_) { nM = M / BM; nN = N / BM; nwg = nM * nN; G = G_; c = c_; }
    __host__ __device__ bool next(int i, Unit& u) const {
        const long L = (long)i * G + c; if (L >= nwg) return false;
        int wgid = (int)L; { const int q = nwg / NXCD, r = nwg % NXCD, xcd = wgid % NXCD, off = wgid / NXCD; wgid = (xcd < r ? xcd * (q + 1) : r * (q + 1) + (xcd - r) * q) + off; }
        const int nig = WGM * nN, gid = wgid / nig, fm = gid * WGM, gsz = (nM - fm) < WGM ? (nM - fm) : WGM;
        u.pm = fm + ((wgid % nig) % gsz); u.pn = (wgid % nig) / gsz; return true;
    }
    __device__ __forceinline__ void a_ready(const Unit&) const {}
    __device__ __forceinline__ void done(const Unit&) const {}
};

__device__ __forceinline__ unsigned cvt_pk_bf16(float lo, float hi) { unsigned r; asm volatile("v_cvt_pk_bf16_f32 %0, %1, %2" : "=v"(r) : "v"(lo), "v"(hi)); return r; }
__device__ __forceinline__ float bf_lo(unsigned w) { return __uint_as_float(w << 16); }
__device__ __forceinline__ float bf_hi(unsigned w) { return __uint_as_float(w & 0xffff0000u); }
__device__ __forceinline__ float sigmoid_f(float x) { return __builtin_amdgcn_rcpf(1.0f + __builtin_amdgcn_exp2f(-1.4426950408889634f * x)); }
__device__ __forceinline__ float silu_f(float x) { return x * sigmoid_f(x); }
__device__ __forceinline__ float gelu_f(float x) { const float y = 1.5957691216057308f * (x + 0.044715f * x * x * x); return x * sigmoid_f(y); }
__device__ __forceinline__ u32x4 pack8(const f32x4 v0, const f32x4 v1) { u32x4 w; w.x = cvt_pk_bf16(v0[0], v0[1]); w.y = cvt_pk_bf16(v0[2], v0[3]); w.z = cvt_pk_bf16(v1[0], v1[1]); w.w = cvt_pk_bf16(v1[2], v1[3]); return w; }

struct EpiSwiGLU {
    static constexpr bool PERM = true, AFTER_DRAIN = false, SWAP = false, MID = false;
    bf16_t* O; int ldc;
    __device__ __forceinline__ bool swapped(const Unit&) const { return false; }
    __device__ __forceinline__ void mid(f32x4 (&)[2][2][4][2], const Unit&, int, int, int, int) const {}
    __device__ __forceinline__ void operator()(const f32x4 (&acc)[2][2][4][2], const Unit& u, int wr, int wc, int fr, int fq) const {
        const int row0 = u.pm * BM + wr * 64 + fr, col0 = u.pn * HALF + wc * 32 + 8 * fq;
#pragma unroll
        for (int ai = 0; ai < 2; ++ai)
#pragma unroll
            for (int m = 0; m < 4; ++m) { bf16_t* rowp = O + (size_t)(row0 + ai * HALF + m * 16) * ldc + col0;
                f32x4 v0, v1;
#pragma unroll
                for (int j = 0; j < 4; ++j) { v0[j] = silu_f(acc[ai][0][m][0][j]) * acc[ai][1][m][0][j]; v1[j] = silu_f(acc[ai][0][m][1][j]) * acc[ai][1][m][1][j]; }
                *(u32x4*)rowp = pack8(v0, v1); }
    }
};
struct EpiBf16S {
    static constexpr bool PERM = true, AFTER_DRAIN = false, SWAP = false, MID = false;
    bf16_t* O; int ldc; const float* scale;
    __device__ __forceinline__ bool swapped(const Unit&) const { return false; }
    __device__ __forceinline__ void mid(f32x4 (&)[2][2][4][2], const Unit&, int, int, int, int) const {}
    __device__ __forceinline__ void operator()(const f32x4 (&acc)[2][2][4][2], const Unit& u, int wr, int wc, int fr, int fq) const {
        const int row0 = u.pm * BM + wr * 64 + fr, col0 = u.pn * BM + wc * 32 + 8 * fq;
        f32x4 sv[2][2];
#pragma unroll
        for (int bj = 0; bj < 2; ++bj)
#pragma unroll
            for (int n = 0; n < 2; ++n) sv[bj][n] = scale ? *(const f32x4*)(scale + col0 + bj * HALF + 4 * n) : (f32x4){1.f, 1.f, 1.f, 1.f};
#pragma unroll
        for (int ai = 0; ai < 2; ++ai)
#pragma unroll
            for (int m = 0; m < 4; ++m) { bf16_t* rowp = O + (size_t)(row0 + ai * HALF + m * 16) * ldc + col0;
#pragma unroll
                for (int bj = 0; bj < 2; ++bj) *(u32x4*)(rowp + bj * HALF) = pack8(acc[ai][bj][m][0] * sv[bj][0], acc[ai][bj][m][1] * sv[bj][1]); }
    }
};
struct EpiInProj {
    static constexpr bool PERM = true, AFTER_DRAIN = false, SWAP = true, MID = false;
    bf16_t *P, *U, *VT, *SGA, *SGB; int Mrows;
    __device__ __forceinline__ bool swapped(const Unit& u) const { return u.pn >= 8 && u.pn < 12; }
    __device__ __forceinline__ void mid(f32x4 (&)[2][2][4][2], const Unit&, int, int, int, int) const {}
    __device__ __forceinline__ void operator()(const f32x4 (&acc)[2][2][4][2], const Unit& u, int wr, int wc, int fr, int fq) const {
        bf16_t* base; int ldc, rbase, cbase, act;
        if (u.pn < 4)       { base = P;   ldc = 1024;  rbase = u.pm * BM;       cbase = u.pn * BM;        act = 0; }
        else if (u.pn < 8)  { base = U;   ldc = 1024;  rbase = u.pm * BM;       cbase = (u.pn - 4) * BM;  act = 1; }
        else if (u.pn < 12) { base = VT;  ldc = Mrows; rbase = (u.pn - 8) * BM; cbase = u.pm * BM;        act = 1; }
        else if (u.pn < 20) { base = SGA; ldc = 2048;  rbase = u.pm * BM;       cbase = (u.pn - 12) * BM; act = 2; }
        else                { base = SGB; ldc = 2048;  rbase = u.pm * BM;       cbase = (u.pn - 20) * BM; act = 2; }
        const int row0 = rbase + wr * 64 + fr, col0 = cbase + wc * 32 + 8 * fq;
#pragma unroll
        for (int ai = 0; ai < 2; ++ai)
#pragma unroll
            for (int m = 0; m < 4; ++m) { bf16_t* rowp = base + (size_t)(row0 + ai * HALF + m * 16) * ldc + col0;
#pragma unroll
                for (int bj = 0; bj < 2; ++bj) { f32x4 v0 = acc[ai][bj][m][0], v1 = acc[ai][bj][m][1];
                    if (act == 1) {
#pragma unroll
                        for (int j = 0; j < 4; ++j) { v0[j] = gelu_f(v0[j]); v1[j] = gelu_f(v1[j]); } }
                    else if (act == 2) {
#pragma unroll
                        for (int j = 0; j < 4; ++j) { v0[j] = sigmoid_f(v0[j]); v1[j] = sigmoid_f(v1[j]); } }
                    *(u32x4*)(rowp + bj * HALF) = pack8(v0, v1); } }
    }
};
struct EpiGate {
    static constexpr bool PERM = true, AFTER_DRAIN = false, SWAP = false, MID = true;
    const bf16_t *SGA, *SGB; bf16_t* O;
    __device__ __forceinline__ bool swapped(const Unit&) const { return false; }
    __device__ __forceinline__ void mid(f32x4 (&acc)[2][2][4][2], const Unit& u, int wr, int wc, int fr, int fq) const {
        const int row0 = u.pm * BM + wr * 64 + fr, col0 = u.pn * BM + wc * 32 + 8 * fq;
#pragma unroll
        for (int ai = 0; ai < 2; ++ai)
#pragma unroll
            for (int m = 0; m < 4; ++m) { const size_t off = (size_t)(row0 + ai * HALF + m * 16) * 2048 + col0;
#pragma unroll
                for (int bj = 0; bj < 2; ++bj) { const u32x4 a = *(const u32x4*)(SGA + off + bj * HALF), b = *(const u32x4*)(SGB + off + bj * HALF);
#pragma unroll
                    for (int k = 0; k < 4; ++k) { const float rl = bf_lo(a[k]) * __builtin_amdgcn_rcpf(fmaxf(bf_lo(b[k]), 1e-30f)), rh = bf_hi(a[k]) * __builtin_amdgcn_rcpf(fmaxf(bf_hi(b[k]), 1e-30f));
                        acc[ai][bj][m][k >> 1][(k & 1) * 2] *= rl; acc[ai][bj][m][k >> 1][(k & 1) * 2 + 1] *= rh; } } }
    }
    __device__ __forceinline__ void operator()(const f32x4 (&acc)[2][2][4][2], const Unit& u, int wr, int wc, int fr, int fq) const {
        const int row0 = u.pm * BM + wr * 64 + fr, col0 = u.pn * BM + wc * 32 + 8 * fq;
#pragma unroll
        for (int ai = 0; ai < 2; ++ai)
#pragma unroll
            for (int m = 0; m < 4; ++m) { const size_t off = (size_t)(row0 + ai * HALF + m * 16) * 2048 + col0;
#pragma unroll
                for (int bj = 0; bj < 2; ++bj) { const u32x4 b = *(const u32x4*)(SGB + off + bj * HALF);
                    const f32x4 s0 = {fmaxf(bf_lo(b[0]), 1e-30f), fmaxf(bf_hi(b[0]), 1e-30f), fmaxf(bf_lo(b[1]), 1e-30f), fmaxf(bf_hi(b[1]), 1e-30f)};
                    const f32x4 s1 = {fmaxf(bf_lo(b[2]), 1e-30f), fmaxf(bf_hi(b[2]), 1e-30f), fmaxf(bf_lo(b[3]), 1e-30f), fmaxf(bf_hi(b[3]), 1e-30f)};
                    *(u32x4*)(O + off + bj * HALF) = pack8(acc[ai][bj][m][0] * s0, acc[ai][bj][m][1] * s1); } }
    }
};

template <class Epi, class Sched, bool ALIGN_EPI = false, bool SP2 = false>
__device__ __forceinline__ void gemm_phase(PG8_LAS unsigned char* lds, const Gemm g, const Sched& S, const Epi& E) {
    int tid = threadIdx.x; asm volatile("" : "+v"(tid));
    const int wid = __builtin_amdgcn_readfirstlane(tid >> 6), lane = tid & 63, wr = wid >> 2, wc = wid & 3, fr = lane & 15, fq = lane >> 4;
    const int K = g.K, nt = K / BK;
    unsigned voffA[2], voffB[2];
#pragma unroll
    for (int i = 0; i < 2; ++i) { int R, C; stage_rc(tid * 16 + i * 8192, R, C); const int Rb = Epi::PERM ? ((R & ~31) + perm32(R & 31)) : R;
        voffA[i] = (unsigned)(R * g.lda + C) * 2u; voffB[i] = (unsigned)(Rb * g.ldb + C) * 2u; }
    const size_t kstep = (size_t)(BK * 2);
    const size_t hstepA = (size_t)HALF * g.lda * 2, hstepB = (size_t)HALF * g.ldb * 2;
    const size_t tstepA = 2 * hstepA, tstepB = 2 * hstepB;
    const unsigned ldsw = (unsigned)wid * 1024u;
    const int aoff = lds_byte(wr * 64 + fr, fq * 8), boff = lds_byte(wc * 32 + fr, fq * 8);
#define PG8_SA(b, h) (((b) * 2 + (h)) * HTB)
#define PG8_SB(b, h) ((4 + (b) * 2 + (h)) * HTB)
#define PG8_STAGE(bufoff, gbase, voff) do { _Pragma("unroll") for (int _i = 0; _i < 2; ++_i) \
        __builtin_amdgcn_global_load_lds((const unsigned*)((const char*)(gbase) + (voff)[_i]), (PG8_LAS unsigned*)(lds + (bufoff) + ldsw + _i * 8192), 16, 0, 0); } while (0)
#define PG8_LDA(dst, b, h) do { _Pragma("unroll") for (int m = 0; m < 4; ++m) _Pragma("unroll") for (int k = 0; k < 2; ++k) dst[m][k] = *(const PG8_LAS bf16x8*)(lds + PG8_SA(b, h) + aoff + m * 2048 + k * 1024); } while (0)
#define PG8_LDB(dst, b, h) do { _Pragma("unroll") for (int n = 0; n < 2; ++n) _Pragma("unroll") for (int k = 0; k < 2; ++k) dst[n][k] = *(const PG8_LAS bf16x8*)(lds + PG8_SB(b, h) + boff + n * 2048 + k * 1024); } while (0)
#define PG8_MMA(ai, bj, At, Bt) do { __builtin_amdgcn_s_setprio(1); _Pragma("unroll") for (int m = 0; m < 4; ++m) _Pragma("unroll") for (int n = 0; n < 2; ++n) _Pragma("unroll") for (int k = 0; k < 2; ++k) \
        acc[ai][bj][m][n] = __builtin_amdgcn_mfma_f32_16x16x32_bf16(Bt[n][k], At[m][k], acc[ai][bj][m][n], 0, 0, 0); __builtin_amdgcn_s_setprio(0); } while (0)
#define PG8_WAIT_V(n) asm volatile("s_waitcnt vmcnt(" #n ")" ::: "memory")
#define PG8_WAIT_L(n) asm volatile("s_waitcnt lgkmcnt(" #n ")" ::: "memory")
#define PG8_BAR __builtin_amdgcn_s_barrier()
#define PG8_SCHED __builtin_amdgcn_sched_barrier(0)
#define PG8_UNIT_PTRS(u, pa, pb) do { const char* _a = (const char*)g.A + (size_t)(u).pm * tstepA + (size_t)(u).pn * (size_t)g.a_pn_koff * 2; const char* _b = (const char*)g.Bt + (size_t)(u).pn * tstepB; \
        if (Epi::SWAP && E.swapped(u)) { pa = _b; pb = _a; } else { pa = _a; pb = _b; } } while (0)
    Unit cur, nxt; int ui = 0;
    if (!S.next(0, cur)) return;
    f32x4 acc[2][2][4][2];
#pragma unroll
    for (int a = 0; a < 2; ++a)
#pragma unroll
        for (int b = 0; b < 2; ++b)
#pragma unroll
            for (int m = 0; m < 4; ++m)
#pragma unroll
                for (int n = 0; n < 2; ++n) acc[a][b][m][n] = (f32x4){0.f, 0.f, 0.f, 0.f};
    bf16x8 At[4][2], B0[2][2], B1[2][2];
    const char* cA; const char* cB; PG8_UNIT_PTRS(cur, cA, cB);
    S.a_ready(cur);
    if constexpr (SP2) {
        PG8_STAGE(PG8_SB(0, 0), cB, voffB); PG8_STAGE(PG8_SB(0, 1), cB + hstepB, voffB); PG8_STAGE(PG8_SA(0, 0), cA, voffA); PG8_STAGE(PG8_SA(0, 1), cA + hstepA, voffA);
        if (wr == 1) PG8_BAR;
        PG8_WAIT_V(2); PG8_BAR;
        PG8_STAGE(PG8_SB(1, 0), cB + kstep, voffB); PG8_STAGE(PG8_SA(1, 0), cA + kstep, voffA); PG8_STAGE(PG8_SB(1, 1), cB + hstepB + kstep, voffB);
        PG8_WAIT_V(6); PG8_BAR;
    } else {
        PG8_STAGE(PG8_SB(0, 0), cB, voffB); PG8_STAGE(PG8_SA(0, 0), cA, voffA); PG8_STAGE(PG8_SB(0, 1), cB + hstepB, voffB); PG8_STAGE(PG8_SA(0, 1), cA + hstepA, voffA);
        if (wr == 1) PG8_BAR;
        PG8_WAIT_V(4); PG8_BAR;
        PG8_STAGE(PG8_SB(1, 0), cB + kstep, voffB); PG8_STAGE(PG8_SA(1, 0), cA + kstep, voffA); PG8_STAGE(PG8_SB(1, 1), cB + hstepB + kstep, voffB);
        PG8_WAIT_V(6); PG8_BAR;
    }
    for (;;) {
        const bool has_next = S.next(ui + 1, nxt);
        const char* nA = cA; const char* nB = cB; if (has_next) PG8_UNIT_PTRS(nxt, nA, nB);
        for (int t = 0; t < nt; t += 2) {
            const bool last = (t == nt - 2);
            const char* a1 = cA + (size_t)(t + 1) * kstep;
            const char* a2 = last ? nA : cA + (size_t)(t + 2) * kstep; const char* b2 = last ? nB : cB + (size_t)(t + 2) * kstep;
            const char* a3 = a2 + kstep; const char* b3 = b2 + kstep;
            if (last && has_next) S.a_ready(nxt);
            if constexpr (Epi::MID) { if (t == (nt >> 1)) { int tz = threadIdx.x; asm volatile("" : "+v"(tz)); const int w2 = __builtin_amdgcn_readfirstlane(tz >> 6), l2 = tz & 63; E.mid(acc, cur, w2 >> 2, w2 & 3, l2 & 15, l2 >> 4); } }
            if constexpr (SP2) {
            PG8_LDB(B0, 0, 0); PG8_LDB(B1, 0, 1); PG8_SCHED; PG8_LDA(At, 0, 0); PG8_STAGE(PG8_SA(1, 1), a1 + hstepA, voffA);
            PG8_WAIT_V(8); PG8_WAIT_L(0); PG8_BAR; PG8_MMA(0, 0, At, B0); PG8_MMA(0, 1, At, B1); PG8_BAR; PG8_SCHED;
            PG8_LDA(At, 0, 1); PG8_STAGE(PG8_SB(0, 0), b2, voffB); PG8_STAGE(PG8_SB(0, 1), b2 + hstepB, voffB); PG8_STAGE(PG8_SA(0, 0), a2, voffA);
            PG8_WAIT_V(8); PG8_WAIT_L(0); PG8_BAR; PG8_MMA(1, 0, At, B0); PG8_MMA(1, 1, At, B1); PG8_BAR; PG8_SCHED;
            PG8_LDB(B0, 1, 0); PG8_LDB(B1, 1, 1); PG8_SCHED; PG8_LDA(At, 1, 0); PG8_STAGE(PG8_SA(0, 1), a2 + hstepA, voffA);
            PG8_WAIT_V(8); PG8_WAIT_L(0); PG8_BAR; PG8_MMA(0, 0, At, B0); PG8_MMA(0, 1, At, B1); PG8_BAR; PG8_SCHED;
            PG8_LDA(At, 1, 1); PG8_STAGE(PG8_SB(1, 0), b3, voffB); PG8_STAGE(PG8_SB(1, 1), b3 + hstepB, voffB); PG8_STAGE(PG8_SA(1, 0), a3, voffA);
            PG8_WAIT_V(8); PG8_WAIT_L(0); PG8_BAR; PG8_MMA(1, 0, At, B0); PG8_MMA(1, 1, At, B1); PG8_BAR; PG8_SCHED;
            } else {
            PG8_LDB(B0, 0, 0); PG8_SCHED; PG8_LDA(At, 0, 0); PG8_STAGE(PG8_SA(1, 1), a1 + hstepA, voffA);
            PG8_WAIT_L(8); PG8_BAR; PG8_WAIT_L(0); PG8_MMA(0, 0, At, B0); PG8_BAR; PG8_SCHED;
            PG8_LDB(B1, 0, 1); PG8_STAGE(PG8_SB(0, 0), b2, voffB);
            PG8_BAR; PG8_WAIT_L(0); PG8_MMA(0, 1, At, B1); PG8_BAR;
            PG8_LDA(At, 0, 1); PG8_STAGE(PG8_SA(0, 0), a2, voffA);
            PG8_BAR; PG8_WAIT_L(0); PG8_MMA(1, 0, At, B0); PG8_BAR; PG8_SCHED;
            PG8_STAGE(PG8_SB(0, 1), b2 + hstepB, voffB);
            PG8_WAIT_V(6); PG8_BAR; PG8_MMA(1, 1, At, B1); PG8_BAR;
            PG8_LDB(B0, 1, 0); PG8_SCHED; PG8_LDA(At, 1, 0); PG8_STAGE(PG8_SA(0, 1), a2 + hstepA, voffA);
            PG8_WAIT_L(8); PG8_BAR; PG8_WAIT_L(0); PG8_MMA(0, 0, At, B0); PG8_BAR; PG8_SCHED;
            PG8_LDB(B1, 1, 1); PG8_STAGE(PG8_SB(1, 0), b3, voffB);
            PG8_BAR; PG8_WAIT_L(0); PG8_MMA(0, 1, At, B1); PG8_BAR;
            PG8_LDA(At, 1, 1); PG8_STAGE(PG8_SA(1, 0), a3, voffA);
            PG8_BAR; PG8_WAIT_L(0); PG8_MMA(1, 0, At, B0); PG8_BAR; PG8_SCHED;
            PG8_STAGE(PG8_SB(1, 1), b3 + hstepB, voffB);
            PG8_WAIT_V(6); PG8_BAR; PG8_MMA(1, 1, At, B1); PG8_BAR;
            }
        }
        if constexpr (ALIGN_EPI) { if (wr == 0) PG8_BAR; }
        { int tz = threadIdx.x; asm volatile("" : "+v"(tz)); const int w2 = __builtin_amdgcn_readfirstlane(tz >> 6), l2 = tz & 63; E(acc, cur, w2 >> 2, w2 & 3, l2 & 15, l2 >> 4); }
        S.done(cur);
        if (!has_next) break;
#pragma unroll
        for (int a = 0; a < 2; ++a)
#pragma unroll
            for (int b = 0; b < 2; ++b)
#pragma unroll
                for (int m = 0; m < 4; ++m)
#pragma unroll
                    for (int n = 0; n < 2; ++n) acc[a][b][m][n] = (f32x4){0.f, 0.f, 0.f, 0.f};
        cur = nxt; cA = nA; cB = nB; ++ui;
        if constexpr (ALIGN_EPI) { if (wr == 1) PG8_BAR; }
    }
    PG8_WAIT_V(0);
    if constexpr (!ALIGN_EPI) { if (wr == 0) PG8_BAR; }
    PG8_BAR;
#undef PG8_SA
#undef PG8_SB
#undef PG8_STAGE
#undef PG8_LDA
#undef PG8_LDB
#undef PG8_MMA
#undef PG8_WAIT_V
#undef PG8_WAIT_L
#undef PG8_BAR
#undef PG8_SCHED
#undef PG8_UNIT_PTRS
}
}

constexpr int NWAVES = 8;
constexpr int BATCH = 4, SEQ = 4096, D = 2048, FF = 5632, NUP = 2 * FF, NIN = 7168, PW = 1024, SW = 1024, NL = 4;
constexpr int M = BATCH * SEQ;
constexpr float EPS = 1e-6f;
constexpr int N_PHASES = 1 + 12 * NL;

constexpr size_t MiB = 1u << 20;
constexpr size_t WS_CTL = 0, CTL_ZERO_BYTES = 1 * MiB;
constexpr size_t WS_W = 2 * MiB;
constexpr size_t LW_UP1 = 0, LW_DN1 = 44 * MiB, LW_WIN = 66 * MiB, LW_WG = 94 * MiB, LW_WPS = 94 * MiB + MiB / 2, LW_WO = 102 * MiB + MiB / 2, LW_UP2 = 110 * MiB + MiB / 2, LW_DN2 = 154 * MiB + MiB / 2;
constexpr size_t LW_STRIDE = 176 * MiB + MiB / 2;
static_assert((size_t)NUP * D * 2 == 44 * MiB && (size_t)D * FF * 2 == 22 * MiB && (size_t)NIN * D * 2 == 28 * MiB && (size_t)1024 * 256 * 2 == MiB / 2 && (size_t)D * D * 2 == 8 * MiB, "weight sizes");
constexpr size_t WS_H = WS_W + NL * LW_STRIDE;
constexpr size_t WS_F = WS_H + 64 * MiB;
constexpr size_t WS_R = WS_F + 64 * MiB;
constexpr size_t WS_ACT = WS_R;
constexpr size_t WS_P = WS_R, WS_U = WS_R + 32 * MiB, WS_VT = WS_R + 64 * MiB, WS_DP = WS_R + 96 * MiB, WS_SGA = WS_R + 128 * MiB, WS_SGB = WS_R + 192 * MiB, WS_YZ = WS_R + 256 * MiB, WS_MM = WS_R + 320 * MiB;
constexpr size_t WS_END = WS_R + 384 * MiB;
static_assert((size_t)M * FF * 2 <= 384 * MiB && WS_H == 708 * MiB, "ws map");
constexpr int CW_BAR = 4096;

constexpr int RING_OFF = 0, RING_BYTES = 131072;
constexpr int LDSCTL_OFF = RING_BYTES, MISC_OFF = LDSCTL_OFF + 320;
constexpr int LDS_BYTES = 147456;
static_assert(MISC_OFF + 128 <= LDS_BYTES, "LDS map");

#define GAS __attribute__((address_space(1)))
#define LAS __attribute__((address_space(3)))
typedef unsigned short bf16;
typedef unsigned v4u __attribute__((ext_vector_type(4)));
typedef unsigned v2u __attribute__((ext_vector_type(2)));
typedef float f32x4 __attribute__((ext_vector_type(4)));
typedef short bf16x8 __attribute__((ext_vector_type(8)));
typedef GAS unsigned gu32;
#define RLX_AGENT __ATOMIC_RELAXED, __HIP_MEMORY_SCOPE_AGENT
#define LDS_WAIT() asm volatile("s_waitcnt lgkmcnt(0)" ::: "memory")
#define VM_WAIT() asm volatile("s_waitcnt vmcnt(0)" ::: "memory")
__device__ __forceinline__ unsigned f2bf(float f) { unsigned u = __builtin_bit_cast(unsigned, f); return (u + 0x7fffu + ((u >> 16) & 1u)) >> 16; }
__device__ __forceinline__ unsigned pk2(float lo, float hi) { return f2bf(lo) | (f2bf(hi) << 16); }
__device__ __forceinline__ float bflo(unsigned w) { return __uint_as_float(w << 16); }
__device__ __forceinline__ float bfhi(unsigned w) { return __uint_as_float(w & 0xffff0000u); }

#define XB_TMO      128
#define XB_XCNT(j)  (256  + 64 * (j))
#define XB_XSUB(j)  (1280 + 64 * (j))
#define XB_XGEN(j)  (2304 + 64 * (j))
#define XB_TOP      3328
#define XB_TOPGEN   3392
#define XCD_BAR_WORDS 3456
#define XB_SPIN_CAP (1u << 18)

__device__ __forceinline__ unsigned xb_ld(unsigned* p)              { return __hip_atomic_load(p, __ATOMIC_RELAXED, __HIP_MEMORY_SCOPE_AGENT); }
__device__ __forceinline__ unsigned xb_add(unsigned* p, unsigned v) { return __hip_atomic_fetch_add(p, v, __ATOMIC_RELAXED, __HIP_MEMORY_SCOPE_AGENT); }
__device__ __forceinline__ unsigned xb_xcc_id() { return (unsigned)__builtin_amdgcn_s_getreg((3 << 11) | 20) & 0xFu; }
#define XB_SPIN(cond, bar) do { unsigned _sp = 0; while (cond) { __builtin_amdgcn_s_sleep(1); \
    if ((++_sp & 255u) == 0u) { if (xb_ld(&(bar)[XB_TMO])) break; if (_sp > XB_SPIN_CAP) { atomicAdd(&(bar)[XB_TMO], 1u); break; } } } } while (0)

struct XcdBarrier {
    unsigned* bar; unsigned x;
    volatile LAS unsigned* st;
};
__device__ __forceinline__ XcdBarrier xcd_barrier_post(unsigned* bar, volatile LAS unsigned* st) {
    XcdBarrier b; b.bar = bar; b.x = xb_xcc_id(); b.st = st;
    if (threadIdx.x == 0) (void)xb_add(&bar[XB_XCNT(b.x)], 1u);
    return b;
}
__device__ __forceinline__ void xcd_barrier_complete(unsigned* bar, unsigned x, unsigned& nloc, unsigned& nx) {
    const unsigned G = gridDim.x * gridDim.y * gridDim.z;
    unsigned sum, cnt, mine, sp = 0u;
    for (;;) {
        sum = 0u; cnt = 0u; mine = 0u;
#pragma unroll
        for (unsigned j = 0; j < 16; ++j) { const unsigned c = xb_ld(&bar[XB_XCNT(j)]); sum += c; cnt += (c > 0u) ? 1u : 0u; mine = (j == x) ? c : mine; }
        if (sum == G) break;
        __builtin_amdgcn_s_sleep(1);
        if ((++sp & 255u) == 0u) { if (xb_ld(&bar[XB_TMO])) break; if (sp > XB_SPIN_CAP) { atomicAdd(&bar[XB_TMO], 1u); break; } }
    }
    nloc = mine > 0u ? mine : 1u; nx = cnt > 0u ? cnt : 1u;
}
__device__ __forceinline__ void xcd_barrier(const XcdBarrier& b) {
    asm volatile("s_waitcnt vmcnt(0)" ::: "memory");
    __syncthreads();
    if (threadIdx.x == 0) {
        unsigned* bar = b.bar;
        __builtin_amdgcn_s_waitcnt(0);
        unsigned nloc = b.st[0], nx = b.st[1];
        if (nloc == 0u) { xcd_barrier_complete(bar, b.x, nloc, nx); b.st[0] = nloc; b.st[1] = nx; }
        const unsigned old = xb_add(&bar[XB_XSUB(b.x)], 1u);
        const unsigned gen = old / nloc;
        if (old + 1u == (gen + 1u) * nloc) {
            __builtin_amdgcn_fence(__ATOMIC_RELEASE, "agent");
            asm volatile("s_waitcnt vmcnt(0)" ::: "memory");
            const unsigned og = xb_add(&bar[XB_TOP], 1u);
            const unsigned tg = og / nx;
            if (og + 1u == (tg + 1u) * nx) xb_add(&bar[XB_TOPGEN], 1u);
            else XB_SPIN(xb_ld(&bar[XB_TOPGEN]) == tg, bar);
            __builtin_amdgcn_fence(__ATOMIC_ACQUIRE, "agent");
            xb_add(&bar[XB_XGEN(b.x)], 1u);
            asm volatile("s_waitcnt vmcnt(0)" ::: "memory");
        } else {
            XB_SPIN(xb_ld(&bar[XB_XGEN(b.x)]) == gen, bar);
            __builtin_amdgcn_fence(__ATOMIC_ACQUIRE, "agent");
            asm volatile("s_waitcnt vmcnt(0)" ::: "memory");
        }
    }
    __syncthreads();
}

struct Frame {
    LAS unsigned char* lds;
    volatile LAS unsigned* MISC;
    gu32* ctl;
    int vcu, G;
};
struct Lane { int tid, lane, wave; };
__device__ __forceinline__ Lane opaque_lane() { int t = threadIdx.x; asm volatile("" : "+v"(t)); Lane q; q.tid = t; q.lane = t & 63; q.wave = __builtin_amdgcn_readfirstlane(t >> 6); return q; }
__device__ __forceinline__ float wave_sum(float v) {
#pragma unroll
    for (int o = 1; o < 64; o <<= 1) v += __shfl_xor(v, o);
    return v;
}

__device__ __forceinline__ void p0_transpose_item(const float* W, int Ns, bf16* WT, int dld, int koff, int mode, LAS float* scr, int item, int lane) {
    const int nblk = Ns / 32, kb = item / nblk, nb = item % nblk, k0 = 64 * kb, n0 = 32 * nb;
    const int n0s = mode ? (((n0 >> 7) & 1) * FF + (n0 >> 8) * 128 + (n0 & 127)) : n0;
#pragma unroll 8
    for (int i = 0; i < 32; ++i) { const int kk = 2 * i + (lane >> 5); scr[kk * 33 + (lane & 31)] = W[(size_t)(k0 + kk) * Ns + n0s + (lane & 31)]; }
    LDS_WAIT(); asm volatile("" ::: "memory");
    const int c = lane & 7;
#pragma unroll
    for (int j = 0; j < 4; ++j) { const int n = (lane >> 3) + 8 * j; const LAS float* s = scr + (8 * c) * 33 + n;
        v4u o; o.x = pk2(s[0 * 33], s[1 * 33]); o.y = pk2(s[2 * 33], s[3 * 33]); o.z = pk2(s[4 * 33], s[5 * 33]); o.w = pk2(s[6 * 33], s[7 * 33]);
        *(v4u*)(WT + (size_t)(n0 + n) * dld + koff + k0 + 8 * c) = o; }
    LDS_WAIT(); asm volatile("" ::: "memory");
}

struct Args { const float* in[20]; float* out; unsigned char* ws; int ph_lo, ph_hi; };

__device__ __forceinline__ void p0_prologue(Frame& F, const Args& args) {
    const Lane T = opaque_lane();
    LAS float* scr = (LAS float*)(F.lds + RING_OFF + T.wave * 16384);
    const int gw = F.vcu * NWAVES + T.wave, NGW = F.G * NWAVES;
    constexpr int I_UP = (D / 64) * (NUP / 32), I_DN = (FF / 64) * (D / 32), I_IN = (D / 64) * (NIN / 32), I_G = 4 * (256 / 64) * (256 / 32), I_PO = (PW / 64) * (D / 32), I_SO = I_PO, I_O = (D / 64) * (D / 32);
    constexpr int PER_LAYER = 2 * I_UP + 2 * I_DN + I_IN + I_G + I_PO + I_SO + I_O;
    constexpr int NITEMS = NL * PER_LAYER;
    for (int it = gw; it < NITEMS; it += NGW) {
        const int l = it / PER_LAYER; int r = it % PER_LAYER;
        unsigned char* wl = args.ws + WS_W + (size_t)l * LW_STRIDE;
        if (r < I_UP) { p0_transpose_item(args.in[2] + (size_t)l * D * NUP, NUP, (bf16*)(wl + LW_UP1), D, 0, 1, scr, r, T.lane); continue; } r -= I_UP;
        if (r < I_DN) { p0_transpose_item(args.in[3] + (size_t)l * FF * D, D, (bf16*)(wl + LW_DN1), FF, 0, 0, scr, r, T.lane); continue; } r -= I_DN;
        if (r < I_IN) { p0_transpose_item(args.in[6] + (size_t)l * D * NIN, NIN, (bf16*)(wl + LW_WIN), D, 0, 0, scr, r, T.lane); continue; } r -= I_IN;
        if (r < I_G)  { const int gi = r / (I_G / 4), ri = r % (I_G / 4);
                        p0_transpose_item(args.in[7] + ((size_t)l * 4 + gi) * 65536, 256, (bf16*)(wl + LW_WG) + (size_t)gi * 65536, 256, 0, 0, scr, ri, T.lane); continue; } r -= I_G;
        if (r < I_PO) { p0_transpose_item(args.in[9] + (size_t)l * PW * D, D, (bf16*)(wl + LW_WPS), 2048, 0, 0, scr, r, T.lane); continue; } r -= I_PO;
        if (r < I_SO) { p0_transpose_item(args.in[13] + (size_t)l * SW * D, D, (bf16*)(wl + LW_WPS), 2048, 1024, 0, scr, r, T.lane); continue; } r -= I_SO;
        if (r < I_O)  { p0_transpose_item(args.in[14] + (size_t)l * D * D, D, (bf16*)(wl + LW_WO), D, 0, 0, scr, r, T.lane); continue; } r -= I_O;
        if (r < I_UP) { p0_transpose_item(args.in[17] + (size_t)l * D * NUP, NUP, (bf16*)(wl + LW_UP2), D, 0, 1, scr, r, T.lane); continue; } r -= I_UP;
        p0_transpose_item(args.in[18] + (size_t)l * FF * D, D, (bf16*)(wl + LW_DN2), FF, 0, 0, scr, r, T.lane);
    }
}

__device__ __forceinline__ void norm_phase(Frame& F, const float* xin, float* xout, const bf16* Fb, const float* gpost, float wgt, const float* gnext, bf16* H) {
    const Lane T = opaque_lane();
    const int gw = F.vcu * NWAVES + T.wave, NGW = F.G * NWAVES;
    for (int m = gw; m < M; m += NGW) {
        const f32x4* xr = (const f32x4*)(xin + (size_t)m * D) + T.lane;
        f32x4 x[8];
#pragma unroll
        for (int j = 0; j < 8; ++j) x[j] = xr[64 * j];
        if (Fb) {
            const v2u* fr = (const v2u*)(Fb + (size_t)m * D) + T.lane;
            f32x4 f[8]; float ss = 0.f;
#pragma unroll
            for (int j = 0; j < 8; ++j) { const v2u w = fr[64 * j]; f[j] = (f32x4){bflo(w.x), bfhi(w.x), bflo(w.y), bfhi(w.y)}; ss += (f[j].x * f[j].x + f[j].y * f[j].y) + (f[j].z * f[j].z + f[j].w * f[j].w); }
            const float rs = wgt * __builtin_amdgcn_rsqf(wave_sum(ss) * (1.f / D) + EPS);
            f32x4* xo = (f32x4*)(xout + (size_t)m * D) + T.lane;
#pragma unroll
            for (int j = 0; j < 8; ++j) { const f32x4 g = ((const f32x4*)gpost)[64 * j + T.lane]; x[j] = x[j] + (f[j] * rs) * g; xo[64 * j] = x[j]; }
        }
        if (gnext) {
            float s2 = 0.f;
#pragma unroll
            for (int j = 0; j < 8; ++j) s2 += (x[j].x * x[j].x + x[j].y * x[j].y) + (x[j].z * x[j].z + x[j].w * x[j].w);
            const float rx = __builtin_amdgcn_rsqf(wave_sum(s2) * (1.f / D) + EPS);
            v2u* ho = (v2u*)(H + (size_t)m * D) + T.lane;
#pragma unroll
            for (int j = 0; j < 8; ++j) { const f32x4 g = ((const f32x4*)gnext)[64 * j + T.lane]; const f32x4 v = (x[j] * rx) * g; v2u w; w.x = pg8::cvt_pk_bf16(v.x, v.y); w.y = pg8::cvt_pk_bf16(v.z, v.w); ho[64 * j] = w; }
        }
    }
}

__device__ __forceinline__ void pool_unit(Frame& F, const bf16* P, bf16* DP, int unit) {
    const Lane T = opaque_lane();
    const int cgi = T.tid & 127, tq = T.tid >> 7, c0 = cgi * 8, w = 2 << (cgi >> 5);
    const int ms = unit * 64 + tq * 16, tl0 = ms & (SEQ - 1);
    float S[8];
#pragma unroll
    for (int k = 0; k < 8; ++k) S[k] = 0.f;
    for (int j = 1; j < w; ++j) if (tl0 - j >= 0) { const v4u q = *(const v4u*)(P + (size_t)(ms - j) * PW + c0);
#pragma unroll
        for (int k = 0; k < 4; ++k) { S[2 * k] += bflo(q[k]); S[2 * k + 1] += bfhi(q[k]); } }
    for (int i = 0; i < 16; ++i) {
        const v4u q = *(const v4u*)(P + (size_t)(ms + i) * PW + c0);
        float cur[8];
#pragma unroll
        for (int k = 0; k < 4; ++k) { cur[2 * k] = bflo(q[k]); cur[2 * k + 1] = bfhi(q[k]); }
        const int cnt = (tl0 + i + 1) < w ? (tl0 + i + 1) : w; const float inv = 1.0f / (float)cnt;
        float d[8];
#pragma unroll
        for (int k = 0; k < 8; ++k) { S[k] += cur[k]; d[k] = S[k] * inv - cur[k]; }
        v4u o; o.x = pg8::cvt_pk_bf16(d[0], d[1]); o.y = pg8::cvt_pk_bf16(d[2], d[3]); o.z = pg8::cvt_pk_bf16(d[4], d[5]); o.w = pg8::cvt_pk_bf16(d[6], d[7]);
        *(v4u*)(DP + (size_t)(ms + i) * PW + c0) = o;
        if (tl0 + i - w + 1 >= 0) { const v4u r = *(const v4u*)(P + (size_t)(ms + i - w + 1) * PW + c0);
#pragma unroll
            for (int k = 0; k < 4; ++k) { S[2 * k] -= bflo(r[k]); S[2 * k + 1] -= bfhi(r[k]); } }
    }
}

constexpr int SGU_WP = 0, SGU_PITCH = 272, SGU_RSTD = 128 * SGU_PITCH, SGU_RED = SGU_RSTD + 512;
__device__ __forceinline__ void sgu_unit(Frame& F, const bf16* VT, const bf16* U, bf16* YZ, const float* Ws, const float* bs, const float* gain, int unit) {
    const Lane T = opaque_lane();
    const int hg = unit & 1, cn = unit >> 1, m0 = cn * 128;
    LAS unsigned char* L = F.lds + RING_OFF;
    LAS float* rstd = (LAS float*)(L + SGU_RSTD); LAS float* red = (LAS float*)(L + SGU_RED);
    { const int tg = T.tid & 15, cg = T.tid >> 4;
      float ss[8];
#pragma unroll
      for (int k = 0; k < 8; ++k) ss[k] = 0.f;
      const bf16* vt = VT + (size_t)(cg * 32) * M + m0 + 8 * tg;
#pragma unroll 8
      for (int c = 0; c < 32; ++c) { const v4u q = *(const v4u*)(vt + (size_t)c * M);
#pragma unroll
          for (int k = 0; k < 4; ++k) { const float lo = bflo(q[k]), hi = bfhi(q[k]); ss[2 * k] += lo * lo; ss[2 * k + 1] += hi * hi; } }
#pragma unroll
      for (int k = 0; k < 8; ++k) { ss[k] += __shfl_xor(ss[k], 16); ss[k] += __shfl_xor(ss[k], 32); }
      if (T.lane < 16) {
#pragma unroll
          for (int k = 0; k < 8; ++k) red[T.wave * 128 + 8 * tg + k] = ss[k]; }
      __syncthreads();
      if (T.tid < 128) { float s = 0.f;
#pragma unroll
          for (int wv = 0; wv < 8; ++wv) s += red[wv * 128 + T.tid];
          rstd[T.tid] = __builtin_amdgcn_rsqf(s * (1.f / SW) + EPS); }
      __syncthreads();
    }
    const int fr = T.lane & 15, fq = T.lane >> 4;
    for (int hh = 0; hh < 4; ++hh) {
        const int h = hg * 4 + hh;
        { const float* Wh = Ws + (size_t)h * 16384; const int t = T.tid >> 2, sb = (T.tid & 3) * 32;
#pragma unroll
          for (int q = 0; q < 4; ++q) { const int s0 = sb + 8 * q;
              const f32x4 w0 = *(const f32x4*)(Wh + t * 128 + s0), w1 = *(const f32x4*)(Wh + t * 128 + s0 + 4);
              const f32x4 r0 = *(const LAS f32x4*)(rstd + s0), r1 = *(const LAS f32x4*)(rstd + s0 + 4);
              float v[8];
#pragma unroll
              for (int j = 0; j < 4; ++j) { v[j] = (s0 + j <= t) ? w0[j] * r0[j] : 0.f; v[4 + j] = (s0 + 4 + j <= t) ? w1[j] * r1[j] : 0.f; }
              v4u o; o.x = pg8::cvt_pk_bf16(v[0], v[1]); o.y = pg8::cvt_pk_bf16(v[2], v[3]); o.z = pg8::cvt_pk_bf16(v[4], v[5]); o.w = pg8::cvt_pk_bf16(v[6], v[7]);
              *(LAS v4u*)(L + SGU_WP + t * SGU_PITCH + s0 * 2) = o; } }
        __syncthreads();
        const int cbase = h * 128 + 16 * T.wave;
        bf16x8 xf[4];
#pragma unroll
        for (int ks = 0; ks < 4; ++ks) xf[ks] = *(const bf16x8*)(VT + (size_t)(cbase + fr) * M + m0 + ks * 32 + 8 * fq);
        f32x4 acc[8];
#pragma unroll
        for (int jt = 0; jt < 8; ++jt) { acc[jt] = (f32x4){0.f, 0.f, 0.f, 0.f};
#pragma unroll
            for (int ks = 0; ks < 4; ++ks) if (32 * ks <= 16 * jt + 15) { const bf16x8 yf = *(const LAS bf16x8*)(L + SGU_WP + (16 * jt + fr) * SGU_PITCH + (ks * 32 + 8 * fq) * 2);
                acc[jt] = __builtin_amdgcn_mfma_f32_16x16x32_bf16(xf[ks], yf, acc[jt], 0, 0, 0); } }
        const int c4 = cbase + 4 * fq; const f32x4 g4 = *(const f32x4*)(gain + c4);
#pragma unroll
        for (int jt = 0; jt < 8; ++jt) { const int t = 16 * jt + fr; const size_t m = (size_t)(m0 + t);
            const float bias = bs[h * 128 + t]; const v2u uu = *(const v2u*)(U + m * SW + c4);
            const float z0 = bflo(uu.x) * (acc[jt][0] * g4[0] + bias), z1 = bfhi(uu.x) * (acc[jt][1] * g4[1] + bias), z2 = bflo(uu.y) * (acc[jt][2] * g4[2] + bias), z3 = bfhi(uu.y) * (acc[jt][3] * g4[3] + bias);
            v2u o; o.x = pg8::cvt_pk_bf16(z0, z1); o.y = pg8::cvt_pk_bf16(z2, z3);
            *(v2u*)(YZ + m * 2048 + 1024 + c4) = o; }
        __syncthreads();
    }
}

#ifndef PG8_SP2
#define PG8_SP2 true
#endif
#ifndef PG8_ALIGN
#define PG8_ALIGN true
#endif

__global__ void __launch_bounds__(NWAVES * 64, 2) mk_fwd(Args args) {
    extern __shared__ __attribute__((aligned(16))) unsigned char lds[];
    Frame F;
    F.lds = (LAS unsigned char*)lds;
    F.MISC = (volatile LAS unsigned*)(F.lds + MISC_OFF);
    F.G = gridDim.x; { const int bx = blockIdx.x; F.vcu = (F.G % 8 == 0) ? (bx % 8) * (F.G / 8) + bx / 8 : bx; }
    unsigned char* ws = args.ws;
    F.ctl = (gu32*)(ws + WS_CTL);
    for (int u = threadIdx.x; u < (LDS_BYTES - LDSCTL_OFF) / 4; u += NWAVES * 64) ((LAS unsigned*)(F.lds + LDSCTL_OFF))[u] = 0u;
    __syncthreads();
    const int lo = args.ph_lo, hi = args.ph_hi;
    XcdBarrier bar; bar.bar = (unsigned*)(F.ctl + CW_BAR); bar.x = 0; bar.st = nullptr;
    if (hi - lo > 1) bar = xcd_barrier_post((unsigned*)(F.ctl + CW_BAR), F.MISC + 8);
#define IN(k) (lo <= (k) && (k) < hi)
#define SEAM(k) do { if (IN(k) && IN((k) + 1)) xcd_barrier(bar); } while (0)

    bf16* const Hb = (bf16*)(ws + WS_H); bf16* const Fb = (bf16*)(ws + WS_F); bf16* const ACT = (bf16*)(ws + WS_ACT);
    bf16* const Pb = (bf16*)(ws + WS_P); bf16* const Ub = (bf16*)(ws + WS_U); bf16* const VT = (bf16*)(ws + WS_VT); bf16* const DP = (bf16*)(ws + WS_DP);
    bf16* const SGA = (bf16*)(ws + WS_SGA); bf16* const SGB = (bf16*)(ws + WS_SGB); bf16* const YZ = (bf16*)(ws + WS_YZ); bf16* const MM = (bf16*)(ws + WS_MM);

    if (IN(0)) { p0_prologue(F, args); norm_phase(F, args.in[0], nullptr, nullptr, nullptr, 0.f, args.in[1], Hb); }
    SEAM(0);

    for (int s = 0; s < 2 * NL; ++s) {
        const int l = s >> 1, second = s & 1, pb = 1 + 12 * l + (second ? 9 : 0);
        unsigned char* wl = ws + WS_W + (size_t)l * LW_STRIDE;
        if (IN(pb)) {
            pg8::Gemm g{Hb, (const bf16*)(wl + (second ? LW_UP2 : LW_UP1)), M, NUP, D, D, D, 0}; pg8::StaticOrder S; S.init(M, NUP, F.G, (int)blockIdx.x);
            pg8::EpiSwiGLU E{ACT, FF};
            pg8::gemm_phase<pg8::EpiSwiGLU, pg8::StaticOrder, PG8_ALIGN, PG8_SP2>(F.lds + RING_OFF, g, S, E);
        }
        SEAM(pb);
        if (IN(pb + 1)) {
            pg8::Gemm g{ACT, (const bf16*)(wl + (second ? LW_DN2 : LW_DN1)), M, D, FF, FF, FF, 0}; pg8::StaticOrder S; S.init(M, D, F.G, (int)blockIdx.x);
            pg8::EpiBf16S E{Fb, D, nullptr};
            pg8::gemm_phase<pg8::EpiBf16S, pg8::StaticOrder, PG8_ALIGN, PG8_SP2>(F.lds + RING_OFF, g, S, E);
        }
        SEAM(pb + 1);
        if (IN(pb + 2)) {
            const float* xin = (s == 0) ? args.in[0] : args.out;
            const float* gpost = (second ? args.in[19] : args.in[4]) + (size_t)l * D;
            const float* gnext = second ? (l + 1 < NL ? args.in[1] + (size_t)(l + 1) * D : nullptr) : args.in[5] + (size_t)l * D;
            norm_phase(F, xin, args.out, Fb, gpost, 0.5f, gnext, Hb);
        }
        SEAM(pb + 2);
        if (!second) {
            if (IN(pb + 3)) {
                pg8::Gemm g{Hb, (const bf16*)(wl + LW_WIN), M, NIN, D, D, D, 0}; pg8::StaticOrder S; S.init(M, NIN, F.G, (int)blockIdx.x);
                pg8::EpiInProj E{Pb, Ub, VT, SGA, SGB, M};
                pg8::gemm_phase<pg8::EpiInProj, pg8::StaticOrder, PG8_ALIGN, PG8_SP2>(F.lds + RING_OFF, g, S, E);
            }
            SEAM(pb + 3);
            if (IN(pb + 4)) {
                for (int u = F.vcu; u < M / 64; u += F.G) pool_unit(F, Pb, DP, u);
                for (int u = F.vcu; u < 2 * (M / 128); u += F.G)
                    sgu_unit(F, VT, Ub, YZ, args.in[11] + (size_t)l * 8 * 16384, args.in[12] + (size_t)l * 8 * 128, args.in[10] + (size_t)l * SW, u);
            }
            SEAM(pb + 4);
            if (IN(pb + 5)) {
                pg8::Gemm g{DP, (const bf16*)(wl + LW_WG), M, PW, 256, PW, 256, 256}; pg8::StaticOrder S; S.init(M, PW, F.G, (int)blockIdx.x);
                pg8::EpiBf16S E{YZ, 2048, args.in[8] + (size_t)l * PW};
                pg8::gemm_phase<pg8::EpiBf16S, pg8::StaticOrder, PG8_ALIGN, PG8_SP2>(F.lds + RING_OFF, g, S, E);
            }
            SEAM(pb + 5);
            if (IN(pb + 6)) {
                pg8::Gemm g{YZ, (const bf16*)(wl + LW_WPS), M, D, 2048, 2048, 2048, 0}; pg8::StaticOrder S; S.init(M, D, F.G, (int)blockIdx.x);
                pg8::EpiGate E{SGA, SGB, MM};
                pg8::gemm_phase<pg8::EpiGate, pg8::StaticOrder, PG8_ALIGN, PG8_SP2>(F.lds + RING_OFF, g, S, E);
            }
            SEAM(pb + 6);
            if (IN(pb + 7)) {
                pg8::Gemm g{MM, (const bf16*)(wl + LW_WO), M, D, D, D, D, 0}; pg8::StaticOrder S; S.init(M, D, F.G, (int)blockIdx.x);
                pg8::EpiBf16S E{Fb, D, nullptr};
                pg8::gemm_phase<pg8::EpiBf16S, pg8::StaticOrder, PG8_ALIGN, PG8_SP2>(F.lds + RING_OFF, g, S, E);
            }
            SEAM(pb + 7);
            if (IN(pb + 8)) norm_phase(F, args.out, args.out, Fb, args.in[15] + (size_t)l * D, 1.0f, args.in[16] + (size_t)l * D, Hb);
            SEAM(pb + 8);
        }
    }
#undef IN
#undef SEAM
}

extern "C" void kernel_launch(void* const* d_in, const int* in_sizes, int n_in, void* d_out, int out_size, void* d_ws, size_t ws_size, hipStream_t stream) {
    static int grid = 0;
    if (grid == 0) {
        if (n_in != 20 || in_sizes[0] != M * D || out_size != M * D || ws_size < WS_END) { fprintf(stderr, "kernel_launch: shape/workspace mismatch: n_in %d in0 %d out %d ws %zu (need %zu)\n", n_in, n_in > 0 ? in_sizes[0] : -1, out_size, ws_size, (size_t)WS_END); grid = -1; return; }
        int dev = 0, cus = 0, per_cu = 0;
        if (hipGetDevice(&dev) != hipSuccess || hipDeviceGetAttribute(&cus, hipDeviceAttributeMultiprocessorCount, dev) != hipSuccess) { fprintf(stderr, "kernel_launch: device query failed\n"); grid = -1; return; }
        if (hipFuncSetAttribute((const void*)mk_fwd, hipFuncAttributeMaxDynamicSharedMemorySize, LDS_BYTES) != hipSuccess) { fprintf(stderr, "kernel_launch: hipFuncSetAttribute failed\n"); grid = -1; return; }
        if (hipOccupancyMaxActiveBlocksPerMultiprocessor(&per_cu, (const void*)mk_fwd, NWAVES * 64, LDS_BYTES) != hipSuccess || per_cu < 1) { fprintf(stderr, "kernel_launch: occupancy query reports %d workgroups per CU\n", per_cu); per_cu = 1; }
        (void)hipGetLastError();
        grid = cus;
    }
    if (grid < 0) return;
    if (hipMemsetAsync((char*)d_ws + WS_CTL, 0, CTL_ZERO_BYTES, stream) != hipSuccess) { fprintf(stderr, "kernel_launch: memset failed\n"); return; }
    Args a{};
    for (int i = 0; i < 20; ++i) a.in[i] = (const float*)d_in[i];
    a.out = (float*)d_out; a.ws = (unsigned char*)d_ws;
#if MK_ONE_LAUNCH
    a.ph_lo = 0; a.ph_hi = N_PHASES;
    hipLaunchKernelGGL(mk_fwd, dim3(grid), dim3(NWAVES * 64), LDS_BYTES, stream, a);
#else
    for (int p = 0; p < N_PHASES; ++p) { a.ph_lo = p; a.ph_hi = p + 1; hipLaunchKernelGGL(mk_fwd, dim3(grid), dim3(NWAVES * 64), LDS_BYTES, stream, a); }
#endif
    const hipError_t le = hipPeekAtLastError();
    if (le != hipSuccess) fprintf(stderr, "kernel_launch: launch failed: %s\n", hipGetErrorName(le));
}
```

```cpp
#include <hip/hip_runtime.h>
#include <cstdio>
#include <cstdint>

#ifndef MK_ONE_LAUNCH
#define MK_ONE_LAUNCH 1
#endif

namespace pg8 {
#define PG8_LAS __attribute__((address_space(3)))
typedef unsigned short bf16_t;
typedef short bf16x8 __attribute__((ext_vector_type(8)));
typedef float f32x4 __attribute__((ext_vector_type(4)));
typedef float f32x2 __attribute__((ext_vector_type(2)));
typedef unsigned u32x4 __attribute__((ext_vector_type(4)));
typedef unsigned u32x2 __attribute__((ext_vector_type(2)));
constexpr int BM = 256, BK = 64, HALF = 128, HTB = HALF * BK * 2  , STAGE_BYTES = 8 * HTB, NXCD = 8, WGM = 8;

__host__ __device__ __forceinline__ int lds_byte(int r, int c) { const int st = (r >> 4) * 2 + (c >> 5), rr = r & 15, cc = c & 31, ob = rr * 64 + cc * 2; return st * 1024 + (ob ^ (((ob >> 9) & 1) << 5)); }
__host__ __device__ __forceinline__ void stage_rc(int b, int& R, int& C) { const int st = b / 1024, sb = b % 1024, swz = sb ^ (((sb >> 9) & 1) << 5); R = (st >> 1) * 16 + swz / 64; C = (st & 1) * 32 + (swz % 64) / 2; }
__host__ __device__ __forceinline__ int perm32(int rho) { const int n = rho >> 4, i = rho & 15; return 8 * (i >> 2) + 4 * n + (i & 3); }

struct Unit { int pm, pn; };
struct Gemm { const bf16_t* A; const bf16_t* Bt; int M, N, K, lda, ldb, a_pn_koff; };

struct StaticOrder {
    int nM, nN, nwg, G, c;
    __host__ __device__ void init(int M, int N, int G_, int c_) { nM = M / BM; nN = N / BM; nwg = nM * nN; G = G_; c = c_; }
    __host__ __device__ bool next(int i, Unit& u) const {
        const long L = (long)i * G + c; if (L >= nwg) return false;
        int wgid = (int)L; { const int q = nwg / NXCD, r = nwg % NXCD, xcd = wgid % NXCD, off = wgid / NXCD; wgid = (xcd < r ? xcd * (q + 1) : r * (q + 1) + (xcd - r) * q) + off; }
        const int nig = WGM * nN, gid = wgid / nig, fm = gid * WGM, gsz = (nM - fm) < WGM ? (nM - fm) : WGM;
        u.pm = fm + ((wgid % nig) % gsz); u.pn = (wgid % nig) / gsz; return true;
    }
    __device__ __forceinline__ void a_ready(const Unit&) const {}
    __device__ __forceinline__ void done(const Unit&) const {}
};

__device__ __forceinline__ unsigned cvt_pk_bf16(float lo, float hi) { unsigned r; asm volatile("v_cvt_pk_bf16_f32 %0, %1, %2" : "=v"(r) : "v"(lo), "v"(hi)); return r; }
__device__ __forceinline__ float bf_lo(unsigned w) { return __uint_as_float(w << 16); }
__device__ __forceinline__ float bf_hi(unsigned w) { return __uint_as_float(w & 0xffff0000u); }
__device__ __forceinline__ float sigmoid_f(float x) { return __builtin_amdgcn_rcpf(1.0f + __builtin_amdgcn_exp2f(-1.4426950408889634f * x)); }
__device__ __forceinline__ float silu_f(float x) { return x * sigmoid_f(x); }
__device__ __forceinline__ float gelu_f(float x) { const float y = 1.5957691216057308f * (x + 0.044715f * x * x * x); return x * sigmoid_f(y); }
__device__ __forceinline__ u32x4 pack8(const f32x4 v0, const f32x4 v1) { u32x4 w; w.x = cvt_pk_bf16(v0[0], v0[1]); w.y = cvt_pk_bf16(v0[2], v0[3]); w.z = cvt_pk_bf16(v1[0], v1[1]); w.w = cvt_pk_bf16(v1[2], v1[3]); return w; }

struct EpiSwiGLU {
    static constexpr bool PERM = true, AFTER_DRAIN = false, SWAP = false, MID = false;
    bf16_t* O; int ldc;
    __device__ __forceinline__ bool swapped(const Unit&) const { return false; }
    __device__ __forceinline__ void mid(f32x4 (&)[2][2][4][2], const Unit&, int, int, int, int) const {}
    __device__ __forceinline__ void operator()(const f32x4 (&acc)[2][2][4][2], const Unit& u, int wr, int wc, int fr, int fq) const {
        const int row0 = u.pm * BM + wr * 64 + fr, col0 = u.pn * HALF + wc * 32 + 8 * fq;
#pragma unroll
        for (int ai = 0; ai < 2; ++ai)
#pragma unroll
            for (int m = 0; m < 4; ++m) { bf16_t* rowp = O + (size_t)(row0 + ai * HALF + m * 16) * ldc + col0;
                f32x4 v0, v1;
#pragma unroll
                for (int j = 0; j < 4; ++j) { v0[j] = silu_f(acc[ai][0][m][0][j]) * acc[ai][1][m][0][j]; v1[j] = silu_f(acc[ai][0][m][1][j]) * acc[ai][1][m][1][j]; }
                *(u32x4*)rowp = pack8(v0, v1); }
    }
};
struct EpiBf16S {
    static constexpr bool PERM = true, AFTER_DRAIN = false, SWAP = false, MID = false;
    bf16_t* O; int ldc; const float* scale;
    __device__ __forceinline__ bool swapped(const Unit&) const { return false; }
    __device__ __forceinline__ void mid(f32x4 (&)[2][2][4][2], const Unit&, int, int, int, int) const {}
    __device__ __forceinline__ void operator()(const f32x4 (&acc)[2][2][4][2], const Unit& u, int wr, int wc, int fr, int fq) const {
        const int row0 = u.pm * BM + wr * 64 + fr, col0 = u.pn * BM + wc * 32 + 8 * fq;
        f32x4 sv[2][2];
#pragma unroll
        for (int bj = 0; bj < 2; ++bj)
#pragma unroll
            for (int n = 0; n < 2; ++n) sv[bj][n] = scale ? *(const f32x4*)(scale + col0 + bj * HALF + 4 * n) : (f32x4){1.f, 1.f, 1.f, 1.f};
#pragma unroll
        for (int ai = 0; ai < 2; ++ai)
#pragma unroll
            for (int m = 0; m < 4; ++m) { bf16_t* rowp = O + (size_t)(row0 + ai * HALF + m * 16) * ldc + col0;
#pragma unroll
                for (int bj = 0; bj < 2; ++bj) *(u32x4*)(rowp + bj * HALF) = pack8(acc[ai][bj][m][0] * sv[bj][0], acc[ai][bj][m][1] * sv[bj][1]); }
    }
};
struct EpiInProj {
    static constexpr bool PERM = true, AFTER_DRAIN = false, SWAP = true, MID = false;
    bf16_t *P, *U, *VT, *SGA, *SGB; int Mrows;
    __device__ __forceinline__ bool swapped(const Unit& u) const { return u.pn >= 8 && u.pn < 12; }
    __device__ __forceinline__ void mid(f32x4 (&)[2][2][4][2], const Unit&, int, int, int, int) const {}
    __device__ __forceinline__ void operator()(const f32x4 (&acc)[2][2][4][2], const Unit& u, int wr, int wc, int fr, int fq) const {
        bf16_t* base; int ldc, rbase, cbase, act;
        if (u.pn < 4)       { base = P;   ldc = 1024;  rbase = u.pm * BM;       cbase = u.pn * BM;        act = 0; }
        else if (u.pn < 8)  { base = U;   ldc = 1024;  rbase = u.pm * BM;       cbase = (u.pn - 4) * BM;  act = 1; }
        else if (u.pn < 12) { base = VT;  ldc = Mrows; rbase = (u.pn - 8) * BM; cbase = u.pm * BM;        act = 1; }
        else if (u.pn < 20) { base = SGA; ldc = 2048;  rbase = u.pm * BM;       cbase = (u.pn - 12) * BM; act = 2; }
        else                { base = SGB; ldc = 2048;  rbase = u.pm * BM;       cbase = (u.pn - 20) * BM; act = 2; }
        const int row0 = rbase + wr * 64 + fr, col0 = cbase + wc * 32 + 8 * fq;
#pragma unroll
        for (int ai = 0; ai < 2; ++ai)
#pragma unroll
            for (int m = 0; m < 4; ++m) { bf16_t* rowp = base + (size_t)(row0 + ai * HALF + m * 16) * ldc + col0;
#pragma unroll
                for (int bj = 0; bj < 2; ++bj) { f32x4 v0 = acc[ai][bj][m][0], v1 = acc[ai][bj][m][1];
                    if (act == 1) {
#pragma unroll
                        for (int j = 0; j < 4; ++j) { v0[j] = gelu_f(v0[j]); v1[j] = gelu_f(v1[j]); } }
                    else if (act == 2) {
#pragma unroll
                        for (int j = 0; j < 4; ++j) { v0[j] = sigmoid_f(v0[j]); v1[j] = sigmoid_f(v1[j]); } }
                    *(u32x4*)(rowp + bj * HALF) = pack8(v0, v1); } }
    }
};
struct EpiGate {
    static constexpr bool PERM = true, AFTER_DRAIN = false, SWAP = false, MID = true;
    const bf16_t *SGA, *SGB; bf16_t* O;
    __device__ __forceinline__ bool swapped(const Unit&) const { return false; }
    __device__ __forceinline__ void mid(f32x4 (&acc)[2][2][4][2], const Unit& u, int wr, int wc, int fr, int fq) const {
        const int row0 = u.pm * BM + wr * 64 + fr, col0 = u.pn * BM + wc * 32 + 8 * fq;
#pragma unroll
        for (int ai = 0; ai < 2; ++ai)
#pragma unroll
            for (int m = 0; m < 4; ++m) { const size_t off = (size_t)(row0 + ai * HALF + m * 16) * 2048 + col0;
#pragma unroll
                for (int bj = 0; bj < 2; ++bj) { const u32x4 a = *(const u32x4*)(SGA + off + bj * HALF), b = *(const u32x4*)(SGB + off + bj * HALF);
#pragma unroll
                    for (int k = 0; k < 4; ++k) { const float rl = bf_lo(a[k]) * __builtin_amdgcn_rcpf(fmaxf(bf_lo(b[k]), 1e-30f)), rh = bf_hi(a[k]) * __builtin_amdgcn_rcpf(fmaxf(bf_hi(b[k]), 1e-30f));
                        acc[ai][bj][m][k >> 1][(k & 1) * 2] *= rl; acc[ai][bj][m][k >> 1][(k & 1) * 2 + 1] *= rh; } } }
    }
    __device__ __forceinline__ void operator()(const f32x4 (&acc)[2][2][4][2], const Unit& u, int wr, int wc, int fr, int fq) const {
        const int row0 = u.pm * BM + wr * 64 + fr, col0 = u.pn * BM + wc * 32 + 8 * fq;
#pragma unroll
        for (int ai = 0; ai < 2; ++ai)
#pragma unroll
            for (int m = 0; m < 4; ++m) { const size_t off = (size_t)(row0 + ai * HALF + m * 16) * 2048 + col0;
#pragma unroll
                for (int bj = 0; bj < 2; ++bj) { const u32x4 b = *(const u32x4*)(SGB + off + bj * HALF);
                    const f32x4 s0 = {fmaxf(bf_lo(b[0]), 1e-30f), fmaxf(bf_hi(b[0]), 1e-30f), fmaxf(bf_lo(b[1]), 1e-30f), fmaxf(bf_hi(b[1]), 1e-30f)};
                    const f32x4 s1 = {fmaxf(bf_lo(b[2]), 1e-30f), fmaxf(bf_hi(b[2]), 1e-30f), fmaxf(bf_lo(b[3]), 1e-30f), fmaxf(bf_hi(b[3]), 1e-30f)};
                    *(u32x4*)(O + off + bj * HALF) = pack8(acc[ai][bj][m][0] * s0, acc[ai][bj][m][1] * s1); } }
    }
};

template <class Epi, class Sched, bool ALIGN_EPI = false, bool SP2 = false>
__device__ __forceinline__ void gemm_phase(PG8_LAS unsigned char* lds, const Gemm g, const Sched& S, const Epi& E) {
    int tid = threadIdx.x; asm volatile("" : "+v"(tid));
    const int wid = __builtin_amdgcn_readfirstlane(tid >> 6), lane = tid & 63, wr = wid >> 2, wc = wid & 3, fr = lane & 15, fq = lane >> 4;
    const int K = g.K, nt = K / BK;
    unsigned voffA[2], voffB[2];
#pragma unroll
    for (int i = 0; i < 2; ++i) { int R, C; stage_rc(tid * 16 + i * 8192, R, C); const int Rb = Epi::PERM ? ((R & ~31) + perm32(R & 31)) : R;
        voffA[i] = (unsigned)(R * g.lda + C) * 2u; voffB[i] = (unsigned)(Rb * g.ldb + C) * 2u; }
    const size_t kstep = (size_t)(BK * 2);
    const size_t hstepA = (size_t)HALF * g.lda * 2, hstepB = (size_t)HALF * g.ldb * 2;
    const size_t tstepA = 2 * hstepA, tstepB = 2 * hstepB;
    const unsigned ldsw = (unsigned)wid * 1024u;
    const int aoff = lds_byte(wr * 64 + fr, fq * 8), boff = lds_byte(wc * 32 + fr, fq * 8);
#define PG8_SA(b, h) (((b) * 2 + (h)) * HTB)
#define PG8_SB(b, h) ((4 + (b) * 2 + (h)) * HTB)
#define PG8_STAGE(bufoff, gbase, voff) do { _Pragma("unroll") for (int _i = 0; _i < 2; ++_i) \
        __builtin_amdgcn_global_load_lds((const unsigned*)((const char*)(gbase) + (voff)[_i]), (PG8_LAS unsigned*)(lds + (bufoff) + ldsw + _i * 8192), 16, 0, 0); } while (0)
#define PG8_LDA(dst, b, h) do { _Pragma("unroll") for (int m = 0; m < 4; ++m) _Pragma("unroll") for (int k = 0; k < 2; ++k) dst[m][k] = *(const PG8_LAS bf16x8*)(lds + PG8_SA(b, h) + aoff + m * 2048 + k * 1024); } while (0)
#define PG8_LDB(dst, b, h) do { _Pragma("unroll") for (int n = 0; n < 2; ++n) _Pragma("unroll") for (int k = 0; k < 2; ++k) dst[n][k] = *(const PG8_LAS bf16x8*)(lds + PG8_SB(b, h) + boff + n * 2048 + k * 1024); } while (0)
#define PG8_MMA(ai, bj, At, Bt) do { __builtin_amdgcn_s_setprio(1); _Pragma("unroll") for (int m = 0; m < 4; ++m) _Pragma("unroll") for (int n = 0; n < 2; ++n) _Pragma("unroll") for (int k = 0; k < 2; ++k) \
        acc[ai][bj][m][n] = __builtin_amdgcn_mfma_f32_16x16x32_bf16(Bt[n][k], At[m][k], acc[ai][bj][m][n], 0, 0, 0); __builtin_amdgcn_s_setprio(0); } while (0)
#define PG8_WAIT_V(n) asm volatile("s_waitcnt vmcnt(" #n ")" ::: "memory")
#define PG8_WAIT_L(n) asm volatile("s_waitcnt lgkmcnt(" #n ")" ::: "memory")
#define PG8_BAR __builtin_amdgcn_s_barrier()
#define PG8_SCHED __builtin_amdgcn_sched_barrier(0)
#define PG8_UNIT_PTRS(u, pa, pb) do { const char* _a = (const char*)g.A + (size_t)(u).pm * tstepA + (size_t)(u).pn * (size_t)g.a_pn_koff * 2; const char* _b = (const char*)g.Bt + (size_t)(u).pn * tstepB; \
        if (Epi::SWAP && E.swapped(u)) { pa = _b; pb = _a; } else { pa = _a; pb = _b; } } while (0)
    Unit cur, nxt; int ui = 0;
    if (!S.next(0, cur)) return;
    f32x4 acc[2][2][4][2];
#pragma unroll
    for (int a = 0; a < 2; ++a)
#pragma unroll
        for (int b = 0; b < 2; ++b)
#pragma unroll
            for (int m = 0; m < 4; ++m)
#pragma unroll
                for (int n = 0; n < 2; ++n) acc[a][b][m][n] = (f32x4){0.f, 0.f, 0.f, 0.f};
    bf16x8 At[4][2], B0[2][2], B1[2][2];
    const char* cA; const char* cB; PG8_UNIT_PTRS(cur, cA, cB);
    S.a_ready(cur);
    if constexpr (SP2) {
        PG8_STAGE(PG8_SB(0, 0), cB, voffB); PG8_STAGE(PG8_SB(0, 1), cB + hstepB, voffB); PG8_STAGE(PG8_SA(0, 0), cA, voffA); PG8_STAGE(PG8_SA(0, 1), cA + hstepA, voffA);
        if (wr == 1) PG8_BAR;
        PG8_WAIT_V(2); PG8_BAR;
        PG8_STAGE(PG8_SB(1, 0), cB + kstep, voffB); PG8_STAGE(PG8_SA(1, 0), cA + kstep, voffA); PG8_STAGE(PG8_SB(1, 1), cB + hstepB + kstep, voffB);
        PG8_WAIT_V(6); PG8_BAR;
    } else {
        PG8_STAGE(PG8_SB(0, 0), cB, voffB); PG8_STAGE(PG8_SA(0, 0), cA, voffA); PG8_STAGE(PG8_SB(0, 1), cB + hstepB, voffB); PG8_STAGE(PG8_SA(0, 1), cA + hstepA, voffA);
        if (wr == 1) PG8_BAR;
        PG8_WAIT_V(4); PG8_BAR;
        PG8_STAGE(PG8_SB(1, 0), cB + kstep, voffB); PG8_STAGE(PG8_SA(1, 0), cA + kstep, voffA); PG8_STAGE(PG8_SB(1, 1), cB + hstepB + kstep, voffB);
        PG8_WAIT_V(6); PG8_BAR;
    }
    for (;;) {
        const bool has_next = S.next(ui + 1, nxt);
        const char* nA = cA; const char* nB = cB; if (has_next) PG8_UNIT_PTRS(nxt, nA, nB);
        for (int t = 0; t < nt; t += 2) {
            const bool last = (t == nt - 2);
            const char* a1 = cA + (size_t)(t + 1) * kstep;
            const char* a2 = last ? nA : cA + (size_t)(t + 2) * kstep; const char* b2 = last ? nB : cB + (size_t)(t + 2) * kstep;
            const char* a3 = a2 + kstep; const char* b3 = b2 + kstep;
            if (last && has_next) S.a_ready(nxt);
            if constexpr (Epi::MID) { if (t == (nt >> 1)) { int tz = threadIdx.x; asm volatile("" : "+v"(tz)); const int w2 = __builtin_amdgcn_readfirstlane(tz >> 6), l2 = tz & 63; E.mid(acc, cur, w2 >> 2, w2 & 3, l2 & 15, l2 >> 4); } }
            if constexpr (SP2) {
            PG8_LDB(B0, 0, 0); PG8_LDB(B1, 0, 1); PG8_SCHED; PG8_LDA(At, 0, 0); PG8_STAGE(PG8_SA(1, 1), a1 + hstepA, voffA);
            PG8_WAIT_V(8); PG8_WAIT_L(0); PG8_BAR; PG8_MMA(0, 0, At, B0); PG8_MMA(0, 1, At, B1); PG8_BAR; PG8_SCHED;
            PG8_LDA(At, 0, 1); PG8_STAGE(PG8_SB(0, 0), b2, voffB); PG8_STAGE(PG8_SB(0, 1), b2 + hstepB, voffB); PG8_STAGE(PG8_SA(0, 0), a2, voffA);
            PG8_WAIT_V(8); PG8_WAIT_L(0); PG8_BAR; PG8_MMA(1, 0, At, B0); PG8_MMA(1, 1, At, B1); PG8_BAR; PG8_SCHED;
            PG8_LDB(B0, 1, 0); PG8_LDB(B1, 1, 1); PG8_SCHED; PG8_LDA(At, 1, 0); PG8_STAGE(PG8_SA(0, 1), a2 + hstepA, voffA);
            PG8_WAIT_V(8); PG8_WAIT_L(0); PG8_BAR; PG8_MMA(0, 0, At, B0); PG8_MMA(0, 1, At, B1); PG8_BAR; PG8_SCHED;
            PG8_LDA(At, 1, 1); PG8_STAGE(PG8_SB(1, 0), b3, voffB); PG8_STAGE(PG8_SB(1, 1), b3 + hstepB, voffB); PG8_STAGE(PG8_SA(1, 0), a3, voffA);
            PG8_WAIT_V(8); PG8_WAIT_L(0); PG8_BAR; PG8_MMA(1, 0, At, B0); PG8_MMA(1, 1, At, B1); PG8_BAR; PG8_SCHED;
            } else {
            PG8_LDB(B0, 0, 0); PG8_SCHED; PG8_LDA(At, 0, 0); PG8_STAGE(PG8_SA(1, 1), a1 + hstepA, voffA);
            PG8_WAIT_L(8); PG8_BAR; PG8_WAIT_L(0); PG8_MMA(0, 0, At, B0); PG8_BAR; PG8_SCHED;
            PG8_LDB(B1, 0, 1); PG8_STAGE(PG8_SB(0, 0), b2, voffB);
            PG8_BAR; PG8_WAIT_L(0); PG8_MMA(0, 1, At, B1); PG8_BAR;
            PG8_LDA(At, 0, 1); PG8_STAGE(PG8_SA(0, 0), a2, voffA);
            PG8_BAR; PG8_WAIT_L(0); PG8_MMA(1, 0, At, B0); PG8_BAR; PG8_SCHED;
            PG8_STAGE(PG8_SB(0, 1), b2 + hstepB, voffB);
            PG8_WAIT_V(6); PG8_BAR; PG8_MMA(1, 1, At, B1); PG8_BAR;
            PG8_LDB(B0, 1, 0); PG8_SCHED; PG8_LDA(At, 1, 0); PG8_STAGE(PG8_SA(0, 1), a2 + hstepA, voffA);
            PG8_WAIT_L(8); PG8_BAR; PG8_WAIT_L(0); PG8_MMA(0, 0, At, B0); PG8_BAR; PG8_SCHED;
            PG8_LDB(B1, 1, 1); PG8_STAGE(PG8_SB(1, 0), b3, voffB);
            PG8_BAR; PG8_WAIT_L(0); PG8_MMA(0, 1, At, B1); PG8_BAR;
            PG8_LDA(At, 1, 1); PG8_STAGE(PG8_SA(1, 0), a3, voffA);
            PG8_BAR; PG8_WAIT_L(0); PG8_MMA(1, 0, At, B0); PG8_BAR; PG8_SCHED;
            PG8_STAGE(PG8_SB(1, 1), b3 + hstepB, voffB);
            PG8_WAIT_V(6); PG8_BAR; PG8_MMA(1, 1, At, B1); PG8_BAR;
            }
        }
        if constexpr (ALIGN_EPI) { if (wr == 0) PG8_BAR; }
        { int tz = threadIdx.x; asm volatile("" : "+v"(tz)); const int w2 = __builtin_amdgcn_readfirstlane(tz >> 6), l2 = tz & 63; E(acc, cur, w2 >> 2, w2 & 3, l2 & 15, l2 >> 4); }
        S.done(cur);
        if (!has_next) break;
#pragma unroll
        for (int a = 0; a < 2; ++a)
#pragma unroll
            for (int b = 0; b < 2; ++b)
#pragma unroll
                for (int m = 0; m < 4; ++m)
#pragma unroll
                    for (int n = 0; n < 2; ++n) acc[a][b][m][n] = (f32x4){0.f, 0.f, 0.f, 0.f};
        cur = nxt; cA = nA; cB = nB; ++ui;
        if constexpr (ALIGN_EPI) { if (wr == 1) PG8_BAR; }
    }
    PG8_WAIT_V(0);
    if constexpr (!ALIGN_EPI) { if (wr == 0) PG8_BAR; }
    PG8_BAR;
#undef PG8_SA
#undef PG8_SB
#undef PG8_STAGE
#undef PG8_LDA
#undef PG8_LDB
#undef PG8_MMA
#undef PG8_WAIT_V
#undef PG8_WAIT_L
#undef PG8_BAR
#undef PG8_SCHED
#undef PG8_UNIT_PTRS
}
}

constexpr int NWAVES = 8;
constexpr int BATCH = 4, SEQ = 4096, D = 2048, FF = 5632, NUP = 2 * FF, NIN = 7168, PW = 1024, SW = 1024, NL = 4;
constexpr int M = BATCH * SEQ;
constexpr float EPS = 1e-6f;
constexpr int N_PHASES = 2 + 11 * NL;

constexpr size_t MiB = 1u << 20;
constexpr size_t WS_CTL = 0, CTL_ZERO_BYTES = 1 * MiB;
constexpr size_t WS_W = 2 * MiB;
constexpr size_t LW_UP1 = 0, LW_DN1 = 44 * MiB, LW_WIN = 66 * MiB, LW_WG = 94 * MiB, LW_WPS = 94 * MiB + MiB / 2, LW_WO = 102 * MiB + MiB / 2, LW_UP2 = 110 * MiB + MiB / 2, LW_DN2 = 154 * MiB + MiB / 2;
constexpr size_t LW_STRIDE = 176 * MiB + MiB / 2;
static_assert((size_t)NUP * D * 2 == 44 * MiB && (size_t)D * FF * 2 == 22 * MiB && (size_t)NIN * D * 2 == 28 * MiB && (size_t)1024 * 256 * 2 == MiB / 2 && (size_t)D * D * 2 == 8 * MiB, "weight sizes");
constexpr size_t WS_H = WS_W + NL * LW_STRIDE;
constexpr size_t WS_F = WS_H + 64 * MiB;
constexpr size_t WS_R = WS_F + 64 * MiB;
constexpr size_t WS_ACT = WS_R;
constexpr size_t WS_P = WS_R, WS_U = WS_R + 32 * MiB, WS_VT = WS_R + 64 * MiB, WS_DP = WS_R + 96 * MiB, WS_SGA = WS_R + 128 * MiB, WS_SGB = WS_R + 192 * MiB, WS_YZ = WS_R + 256 * MiB, WS_MM = WS_R + 320 * MiB;
constexpr size_t WS_END = WS_R + 384 * MiB;
constexpr size_t WS_TPO = WS_R, WS_TGS = WS_R + 16 * MiB;
static_assert((size_t)M * FF * 2 <= 384 * MiB && WS_H == 708 * MiB, "ws map");
constexpr int CW_BAR = 4096;

constexpr int RING_OFF = 0, RING_BYTES = 131072;
constexpr int LDSCTL_OFF = RING_BYTES, MISC_OFF = LDSCTL_OFF + 320;
constexpr int LDS_BYTES = 147456;
static_assert(MISC_OFF + 128 <= LDS_BYTES, "LDS map");

#define GAS __attribute__((address_space(1)))
#define LAS __attribute__((address_space(3)))
typedef unsigned short bf16;
typedef unsigned v4u __attribute__((ext_vector_type(4)));
typedef unsigned v2u __attribute__((ext_vector_type(2)));
typedef float f32x4 __attribute__((ext_vector_type(4)));
typedef short bf16x8 __attribute__((ext_vector_type(8)));
typedef GAS unsigned gu32;
#define RLX_AGENT __ATOMIC_RELAXED, __HIP_MEMORY_SCOPE_AGENT
#define LDS_WAIT() asm volatile("s_waitcnt lgkmcnt(0)" ::: "memory")
#define VM_WAIT() asm volatile("s_waitcnt vmcnt(0)" ::: "memory")
__device__ __forceinline__ unsigned f2bf(float f) { unsigned u = __builtin_bit_cast(unsigned, f); return (u + 0x7fffu + ((u >> 16) & 1u)) >> 16; }
__device__ __forceinline__ unsigned pk2(float lo, float hi) { return f2bf(lo) | (f2bf(hi) << 16); }
__device__ __forceinline__ float bflo(unsigned w) { return __uint_as_float(w << 16); }
__device__ __forceinline__ float bfhi(unsigned w) { return __uint_as_float(w & 0xffff0000u); }

#define XB_TMO      128
#define XB_XCNT(j)  (256  + 64 * (j))
#define XB_XSUB(j)  (1280 + 64 * (j))
#define XB_XGEN(j)  (2304 + 64 * (j))
#define XB_TOP      3328
#define XB_TOPGEN   3392
#define XCD_BAR_WORDS 3456
#define XB_SPIN_CAP (1u << 18)

__device__ __forceinline__ unsigned xb_ld(unsigned* p)              { return __hip_atomic_load(p, __ATOMIC_RELAXED, __HIP_MEMORY_SCOPE_AGENT); }
__device__ __forceinline__ unsigned xb_add(unsigned* p, unsigned v) { return __hip_atomic_fetch_add(p, v, __ATOMIC_RELAXED, __HIP_MEMORY_SCOPE_AGENT); }
__device__ __forceinline__ unsigned xb_xcc_id() { return (unsigned)__builtin_amdgcn_s_getreg((3 << 11) | 20) & 0xFu; }
#define XB_SPIN(cond, bar) do { unsigned _sp = 0; while (cond) { __builtin_amdgcn_s_sleep(1); \
    if ((++_sp & 255u) == 0u) { if (xb_ld(&(bar)[XB_TMO])) break; if (_sp > XB_SPIN_CAP) { atomicAdd(&(bar)[XB_TMO], 1u); break; } } } } while (0)

struct XcdBarrier {
    unsigned* bar; unsigned x;
    volatile LAS unsigned* st;
};
__device__ __forceinline__ XcdBarrier xcd_barrier_post(unsigned* bar, volatile LAS unsigned* st) {
    XcdBarrier b; b.bar = bar; b.x = xb_xcc_id(); b.st = st;
    if (threadIdx.x == 0) (void)xb_add(&bar[XB_XCNT(b.x)], 1u);
    return b;
}
__device__ __forceinline__ void xcd_barrier_complete(unsigned* bar, unsigned x, unsigned& nloc, unsigned& nx) {
    const unsigned G = gridDim.x * gridDim.y * gridDim.z;
    unsigned sum, cnt, mine, sp = 0u;
    for (;;) {
        sum = 0u; cnt = 0u; mine = 0u;
#pragma unroll
        for (unsigned j = 0; j < 16; ++j) { const unsigned c = xb_ld(&bar[XB_XCNT(j)]); sum += c; cnt += (c > 0u) ? 1u : 0u; mine = (j == x) ? c : mine; }
        if (sum == G) break;
        __builtin_amdgcn_s_sleep(1);
        if ((++sp & 255u) == 0u) { if (xb_ld(&bar[XB_TMO])) break; if (sp > XB_SPIN_CAP) { atomicAdd(&bar[XB_TMO], 1u); break; } }
    }
    nloc = mine > 0u ? mine : 1u; nx = cnt > 0u ? cnt : 1u;
}
__device__ __forceinline__ void xcd_barrier(const XcdBarrier& b) {
    asm volatile("s_waitcnt vmcnt(0)" ::: "memory");
    __syncthreads();
    if (threadIdx.x == 0) {
        unsigned* bar = b.bar;
        __builtin_amdgcn_s_waitcnt(0);
        unsigned nloc = b.st[0], nx = b.st[1];
        if (nloc == 0u) { xcd_barrier_complete(bar, b.x, nloc, nx); b.st[0] = nloc; b.st[1] = nx; }
        const unsigned old = xb_add(&bar[XB_XSUB(b.x)], 1u);
        const unsigned gen = old / nloc;
        if (old + 1u == (gen + 1u) * nloc) {
            __builtin_amdgcn_fence(__ATOMIC_RELEASE, "agent");
            asm volatile("s_waitcnt vmcnt(0)" ::: "memory");
            const unsigned og = xb_add(&bar[XB_TOP], 1u);
            const unsigned tg = og / nx;
            if (og + 1u == (tg + 1u) * nx) xb_add(&bar[XB_TOPGEN], 1u);
            else XB_SPIN(xb_ld(&bar[XB_TOPGEN]) == tg, bar);
            __builtin_amdgcn_fence(__ATOMIC_ACQUIRE, "agent");
            xb_add(&bar[XB_XGEN(b.x)], 1u);
            asm volatile("s_waitcnt vmcnt(0)" ::: "memory");
        } else {
            XB_SPIN(xb_ld(&bar[XB_XGEN(b.x)]) == gen, bar);
            __builtin_amdgcn_fence(__ATOMIC_ACQUIRE, "agent");
            asm volatile("s_waitcnt vmcnt(0)" ::: "memory");
        }
    }
    __syncthreads();
}

struct Frame {
    LAS unsigned char* lds;
    volatile LAS unsigned* MISC;
    gu32* ctl;
    int vcu, G;
};
struct Lane { int tid, lane, wave; };
__device__ __forceinline__ Lane opaque_lane() { int t = threadIdx.x; asm volatile("" : "+v"(t)); Lane q; q.tid = t; q.lane = t & 63; q.wave = __builtin_amdgcn_readfirstlane(t >> 6); return q; }
__device__ __forceinline__ float wave_sum(float v) {
#pragma unroll
    for (int o = 1; o < 64; o <<= 1) v += __shfl_xor(v, o);
    return v;
}

__device__ __forceinline__ void p0_transpose_item(const float* W, int Ns, bf16* WT, int dld, int koff, int mode, LAS float* scr, int item, int lane) {
    const int nblk = Ns / 32, kb = item / nblk, nb = item % nblk, k0 = 64 * kb, n0 = 32 * nb;
    const int n0s = mode ? (((n0 >> 7) & 1) * FF + (n0 >> 8) * 128 + (n0 & 127)) : n0;
#pragma unroll 8
    for (int i = 0; i < 32; ++i) { const int kk = 2 * i + (lane >> 5); scr[kk * 33 + (lane & 31)] = W[(size_t)(k0 + kk) * Ns + n0s + (lane & 31)]; }
    LDS_WAIT(); asm volatile("" ::: "memory");
    const int c = lane & 7;
#pragma unroll
    for (int j = 0; j < 4; ++j) { const int n = (lane >> 3) + 8 * j; const LAS float* s = scr + (8 * c) * 33 + n;
        v4u o; o.x = pk2(s[0 * 33], s[1 * 33]); o.y = pk2(s[2 * 33], s[3 * 33]); o.z = pk2(s[4 * 33], s[5 * 33]); o.w = pk2(s[6 * 33], s[7 * 33]);
        *(v4u*)(WT + (size_t)(n0 + n) * dld + koff + k0 + 8 * c) = o; }
    LDS_WAIT(); asm volatile("" ::: "memory");
}

struct Args { const float* in[20]; float* out; unsigned char* ws; int ph_lo, ph_hi; };

__device__ __forceinline__ void p0_prologue(Frame& F, const Args& args) {
    const Lane T = opaque_lane();
    LAS float* scr = (LAS float*)(F.lds + RING_OFF + T.wave * 16384);
    const int gw = F.vcu * NWAVES + T.wave, NGW = F.G * NWAVES;
    constexpr int I_UP = (D / 64) * (NUP / 32), I_DN = (FF / 64) * (D / 32), I_IN = (D / 64) * (NIN / 32), I_G = 4 * 256 * 256 / 2048, I_PO = (PW / 64) * (D / 32), I_SO = I_PO, I_O = (D / 64) * (D / 32);
    constexpr int PER_LAYER = 2 * I_UP + 2 * I_DN + I_IN + I_G + I_PO + I_SO + I_O;
    constexpr int NITEMS = NL * PER_LAYER;
    for (int it = gw; it < NITEMS; it += NGW) {
        const int l = it / PER_LAYER; int r = it % PER_LAYER;
        unsigned char* wl = args.ws + WS_W + (size_t)l * LW_STRIDE;
        if (r < I_UP) { p0_transpose_item(args.in[2] + (size_t)l * D * NUP, NUP, (bf16*)(wl + LW_UP1), D, 0, 1, scr, r, T.lane); continue; } r -= I_UP;
        if (r < I_DN) { p0_transpose_item(args.in[3] + (size_t)l * FF * D, D, (bf16*)(wl + LW_DN1), FF, 0, 0, scr, r, T.lane); continue; } r -= I_DN;
        if (r < I_IN) { p0_transpose_item(args.in[6] + (size_t)l * D * NIN, NIN, (bf16*)(wl + LW_WIN), D, 0, 0, scr, r, T.lane); continue; } r -= I_IN;
        if (r < I_G)  {
                        const float* src = args.in[7] + (size_t)l * 262144 + (size_t)r * 2048; const float* sc = args.in[8] + (size_t)l * PW + (r >> 5) * 256 + 4 * T.lane;
                        bf16* dst = (bf16*)(args.ws + WS_TGS + (size_t)l * (MiB / 2)) + (size_t)r * 2048; const f32x4 sv = *(const f32x4*)sc;
#pragma unroll
                        for (int p = 0; p < 8; ++p) { const f32x4 v = *(const f32x4*)(src + p * 256 + 4 * T.lane) * sv; v2u o; o.x = pk2(v.x, v.y); o.y = pk2(v.z, v.w); *(v2u*)(dst + p * 256 + 4 * T.lane) = o; }
                        continue; } r -= I_G;
        if (r < I_PO) { p0_transpose_item(args.in[9] + (size_t)l * PW * D, D, (bf16*)(args.ws + WS_TPO + (size_t)l * 4 * MiB), 1024, 0, 0, scr, r, T.lane); continue; } r -= I_PO;
        if (r < I_SO) { p0_transpose_item(args.in[13] + (size_t)l * SW * D, D, (bf16*)(wl + LW_WPS), 2048, 1024, 0, scr, r, T.lane); continue; } r -= I_SO;
        if (r < I_O)  { p0_transpose_item(args.in[14] + (size_t)l * D * D, D, (bf16*)(wl + LW_WO), D, 0, 0, scr, r, T.lane); continue; } r -= I_O;
        if (r < I_UP) { p0_transpose_item(args.in[17] + (size_t)l * D * NUP, NUP, (bf16*)(wl + LW_UP2), D, 0, 1, scr, r, T.lane); continue; } r -= I_UP;
        p0_transpose_item(args.in[18] + (size_t)l * FF * D, D, (bf16*)(wl + LW_DN2), FF, 0, 0, scr, r, T.lane);
    }
}

__device__ __forceinline__ void norm_phase(Frame& F, const float* xin, float* xout, const bf16* Fb, const float* gpost, float wgt, const float* gnext, bf16* H) {
    const Lane T = opaque_lane();
    const int gw = F.vcu * NWAVES + T.wave, NGW = F.G * NWAVES;
    for (int m = gw; m < M; m += NGW) {
        const f32x4* xr = (const f32x4*)(xin + (size_t)m * D) + T.lane;
        f32x4 x[8];
#pragma unroll
        for (int j = 0; j < 8; ++j) x[j] = xr[64 * j];
        if (Fb) {
            const v2u* fr = (const v2u*)(Fb + (size_t)m * D) + T.lane;
            f32x4 f[8]; float ss = 0.f;
#pragma unroll
            for (int j = 0; j < 8; ++j) { const v2u w = fr[64 * j]; f[j] = (f32x4){bflo(w.x), bfhi(w.x), bflo(w.y), bfhi(w.y)}; ss += (f[j].x * f[j].x + f[j].y * f[j].y) + (f[j].z * f[j].z + f[j].w * f[j].w); }
            const float rs = wgt * __builtin_amdgcn_rsqf(wave_sum(ss) * (1.f / D) + EPS);
            f32x4* xo = (f32x4*)(xout + (size_t)m * D) + T.lane;
#pragma unroll
            for (int j = 0; j < 8; ++j) { const f32x4 g = ((const f32x4*)gpost)[64 * j + T.lane]; x[j] = x[j] + (f[j] * rs) * g; xo[64 * j] = x[j]; }
        }
        if (gnext) {
            float s2 = 0.f;
#pragma unroll
            for (int j = 0; j < 8; ++j) s2 += (x[j].x * x[j].x + x[j].y * x[j].y) + (x[j].z * x[j].z + x[j].w * x[j].w);
            const float rx = __builtin_amdgcn_rsqf(wave_sum(s2) * (1.f / D) + EPS);
            v2u* ho = (v2u*)(H + (size_t)m * D) + T.lane;
#pragma unroll
            for (int j = 0; j < 8; ++j) { const f32x4 g = ((const f32x4*)gnext)[64 * j + T.lane]; const f32x4 v = (x[j] * rx) * g; v2u w; w.x = pg8::cvt_pk_bf16(v.x, v.y); w.y = pg8::cvt_pk_bf16(v.z, v.w); ho[64 * j] = w; }
        }
    }
}

__device__ __forceinline__ void pool_unit(Frame& F, const bf16* P, bf16* DP, int unit) {
    const Lane T = opaque_lane();
    const int cgi = T.tid & 127, tq = T.tid >> 7, c0 = cgi * 8, w = 2 << (cgi >> 5);
    const int ms = unit * 64 + tq * 16, tl0 = ms & (SEQ - 1);
    float S[8];
#pragma unroll
    for (int k = 0; k < 8; ++k) S[k] = 0.f;
    for (int j = 1; j < w; ++j) if (tl0 - j >= 0) { const v4u q = *(const v4u*)(P + (size_t)(ms - j) * PW + c0);
#pragma unroll
        for (int k = 0; k < 4; ++k) { S[2 * k] += bflo(q[k]); S[2 * k + 1] += bfhi(q[k]); } }
    for (int i = 0; i < 16; ++i) {
        const v4u q = *(const v4u*)(P + (size_t)(ms + i) * PW + c0);
        float cur[8];
#pragma unroll
        for (int k = 0; k < 4; ++k) { cur[2 * k] = bflo(q[k]); cur[2 * k + 1] = bfhi(q[k]); }
        const int cnt = (tl0 + i + 1) < w ? (tl0 + i + 1) : w; const float inv = 1.0f / (float)cnt;
        float d[8];
#pragma unroll
        for (int k = 0; k < 8; ++k) { S[k] += cur[k]; d[k] = S[k] * inv - cur[k]; }
        v4u o; o.x = pg8::cvt_pk_bf16(d[0], d[1]); o.y = pg8::cvt_pk_bf16(d[2], d[3]); o.z = pg8::cvt_pk_bf16(d[4], d[5]); o.w = pg8::cvt_pk_bf16(d[6], d[7]);
        *(v4u*)(DP + (size_t)(ms + i) * 2048 + c0) = o;
        if (tl0 + i - w + 1 >= 0) { const v4u r = *(const v4u*)(P + (size_t)(ms + i - w + 1) * PW + c0);
#pragma unroll
            for (int k = 0; k < 4; ++k) { S[2 * k] -= bflo(r[k]); S[2 * k + 1] -= bfhi(r[k]); } }
    }
}

constexpr int SGU_WP = 0, SGU_PITCH = 272, SGU_RSTD = 128 * SGU_PITCH, SGU_RED = SGU_RSTD + 512;
__device__ __forceinline__ void sgu_unit(Frame& F, const bf16* VT, const bf16* U, bf16* YZ, const float* Ws, const float* bs, const float* gain, int unit) {
    const Lane T = opaque_lane();
    const int hg = unit & 1, cn = unit >> 1, m0 = cn * 128;
    LAS unsigned char* L = F.lds + RING_OFF;
    LAS float* rstd = (LAS float*)(L + SGU_RSTD); LAS float* red = (LAS float*)(L + SGU_RED);
    { const int tg = T.tid & 15, cg = T.tid >> 4;
      float ss[8];
#pragma unroll
      for (int k = 0; k < 8; ++k) ss[k] = 0.f;
      const bf16* vt = VT + (size_t)(cg * 32) * M + m0 + 8 * tg;
#pragma unroll 8
      for (int c = 0; c < 32; ++c) { const v4u q = *(const v4u*)(vt + (size_t)c * M);
#pragma unroll
          for (int k = 0; k < 4; ++k) { const float lo = bflo(q[k]), hi = bfhi(q[k]); ss[2 * k] += lo * lo; ss[2 * k + 1] += hi * hi; } }
#pragma unroll
      for (int k = 0; k < 8; ++k) { ss[k] += __shfl_xor(ss[k], 16); ss[k] += __shfl_xor(ss[k], 32); }
      if (T.lane < 16) {
#pragma unroll
          for (int k = 0; k < 8; ++k) red[T.wave * 128 + 8 * tg + k] = ss[k]; }
      __syncthreads();
      if (T.tid < 128) { float s = 0.f;
#pragma unroll
          for (int wv = 0; wv < 8; ++wv) s += red[wv * 128 + T.tid];
          rstd[T.tid] = __builtin_amdgcn_rsqf(s * (1.f / SW) + EPS); }
      __syncthreads();
    }
    const int fr = T.lane & 15, fq = T.lane >> 4;
    for (int hh = 0; hh < 4; ++hh) {
        const int h = hg * 4 + hh;
        { const float* Wh = Ws + (size_t)h * 16384; const int t = T.tid >> 2, sb = (T.tid & 3) * 32;
#pragma unroll
          for (int q = 0; q < 4; ++q) { const int s0 = sb + 8 * q;
              const f32x4 w0 = *(const f32x4*)(Wh + t * 128 + s0), w1 = *(const f32x4*)(Wh + t * 128 + s0 + 4);
              const f32x4 r0 = *(const LAS f32x4*)(rstd + s0), r1 = *(const LAS f32x4*)(rstd + s0 + 4);
              float v[8];
#pragma unroll
              for (int j = 0; j < 4; ++j) { v[j] = (s0 + j <= t) ? w0[j] * r0[j] : 0.f; v[4 + j] = (s0 + 4 + j <= t) ? w1[j] * r1[j] : 0.f; }
              v4u o; o.x = pg8::cvt_pk_bf16(v[0], v[1]); o.y = pg8::cvt_pk_bf16(v[2], v[3]); o.z = pg8::cvt_pk_bf16(v[4], v[5]); o.w = pg8::cvt_pk_bf16(v[6], v[7]);
              *(LAS v4u*)(L + SGU_WP + t * SGU_PITCH + s0 * 2) = o; } }
        __syncthreads();
        const int cbase = h * 128 + 16 * T.wave;
        bf16x8 xf[4];
#pragma unroll
        for (int ks = 0; ks < 4; ++ks) xf[ks] = *(const bf16x8*)(VT + (size_t)(cbase + fr) * M + m0 + ks * 32 + 8 * fq);
        f32x4 acc[8];
#pragma unroll
        for (int jt = 0; jt < 8; ++jt) { acc[jt] = (f32x4){0.f, 0.f, 0.f, 0.f};
#pragma unroll
            for (int ks = 0; ks < 4; ++ks) if (32 * ks <= 16 * jt + 15) { const bf16x8 yf = *(const LAS bf16x8*)(L + SGU_WP + (16 * jt + fr) * SGU_PITCH + (ks * 32 + 8 * fq) * 2);
                acc[jt] = __builtin_amdgcn_mfma_f32_16x16x32_bf16(xf[ks], yf, acc[jt], 0, 0, 0); } }
        const int c4 = cbase + 4 * fq; const f32x4 g4 = *(const f32x4*)(gain + c4);
#pragma unroll
        for (int jt = 0; jt < 8; ++jt) { const int t = 16 * jt + fr; const size_t m = (size_t)(m0 + t);
            const float bias = bs[h * 128 + t]; const v2u uu = *(const v2u*)(U + m * SW + c4);
            const float z0 = bflo(uu.x) * (acc[jt][0] * g4[0] + bias), z1 = bfhi(uu.x) * (acc[jt][1] * g4[1] + bias), z2 = bflo(uu.y) * (acc[jt][2] * g4[2] + bias), z3 = bfhi(uu.y) * (acc[jt][3] * g4[3] + bias);
            v2u o; o.x = pg8::cvt_pk_bf16(z0, z1); o.y = pg8::cvt_pk_bf16(z2, z3);
            *(v2u*)(YZ + m * 2048 + 1024 + c4) = o; }
        __syncthreads();
    }
}

#ifndef PG8_SP2
#define PG8_SP2 true
#endif
#ifndef PG8_ALIGN
#define PG8_ALIGN true
#endif

__global__ void __launch_bounds__(NWAVES * 64, 2) mk_fwd(Args args) {
    extern __shared__ __attribute__((aligned(16))) unsigned char lds[];
    Frame F;
    F.lds = (LAS unsigned char*)lds;
    F.MISC = (volatile LAS unsigned*)(F.lds + MISC_OFF);
    F.G = gridDim.x; { const int bx = blockIdx.x; F.vcu = (F.G % 8 == 0) ? (bx % 8) * (F.G / 8) + bx / 8 : bx; }
    unsigned char* ws = args.ws;
    F.ctl = (gu32*)(ws + WS_CTL);
    for (int u = threadIdx.x; u < (LDS_BYTES - LDSCTL_OFF) / 4; u += NWAVES * 64) ((LAS unsigned*)(F.lds + LDSCTL_OFF))[u] = 0u;
    __syncthreads();
    const int lo = args.ph_lo, hi = args.ph_hi;
    XcdBarrier bar; bar.bar = (unsigned*)(F.ctl + CW_BAR); bar.x = 0; bar.st = nullptr;
    if (hi - lo > 1) bar = xcd_barrier_post((unsigned*)(F.ctl + CW_BAR), F.MISC + 8);
#define IN(k) (lo <= (k) && (k) < hi)
#define SEAM(k) do { if (IN(k) && IN((k) + 1)) xcd_barrier(bar); } while (0)

    bf16* const Hb = (bf16*)(ws + WS_H); bf16* const Fb = (bf16*)(ws + WS_F); bf16* const ACT = (bf16*)(ws + WS_ACT);
    bf16* const Pb = (bf16*)(ws + WS_P); bf16* const Ub = (bf16*)(ws + WS_U); bf16* const VT = (bf16*)(ws + WS_VT);
    bf16* const SGA = (bf16*)(ws + WS_SGA); bf16* const SGB = (bf16*)(ws + WS_SGB); bf16* const YZ = (bf16*)(ws + WS_YZ); bf16* const MM = (bf16*)(ws + WS_MM);

    if (IN(0)) { p0_prologue(F, args); norm_phase(F, args.in[0], nullptr, nullptr, nullptr, 0.f, args.in[1], Hb); }
    SEAM(0);
    if (IN(1)) {
        const int fl = (int)blockIdx.x >> 5;
        if (fl < NL) {
            pg8::Gemm g{(const bf16*)(ws + WS_TPO + (size_t)fl * 4 * MiB), (const bf16*)(ws + WS_TGS + (size_t)fl * (MiB / 2)), D, PW, 256, PW, 256, 256}; pg8::StaticOrder S; S.init(D, PW, 32, (int)blockIdx.x & 31);
            pg8::EpiBf16S E{(bf16*)(ws + WS_W + (size_t)fl * LW_STRIDE + LW_WPS), 2048, nullptr};
            pg8::gemm_phase<pg8::EpiBf16S, pg8::StaticOrder, PG8_ALIGN, PG8_SP2>(F.lds + RING_OFF, g, S, E);
        }
    }
    SEAM(1);

    for (int s = 0; s < 2 * NL; ++s) {
        const int l = s >> 1, second = s & 1, pb = 2 + 11 * l + (second ? 8 : 0);
        unsigned char* wl = ws + WS_W + (size_t)l * LW_STRIDE;
        if (IN(pb)) {
            pg8::Gemm g{Hb, (const bf16*)(wl + (second ? LW_UP2 : LW_UP1)), M, NUP, D, D, D, 0}; pg8::StaticOrder S; S.init(M, NUP, F.G, (int)blockIdx.x);
            pg8::EpiSwiGLU E{ACT, FF};
            pg8::gemm_phase<pg8::EpiSwiGLU, pg8::StaticOrder, PG8_ALIGN, PG8_SP2>(F.lds + RING_OFF, g, S, E);
        }
        SEAM(pb);
        if (IN(pb + 1)) {
            pg8::Gemm g{ACT, (const bf16*)(wl + (second ? LW_DN2 : LW_DN1)), M, D, FF, FF, FF, 0}; pg8::StaticOrder S; S.init(M, D, F.G, (int)blockIdx.x);
            pg8::EpiBf16S E{Fb, D, nullptr};
            pg8::gemm_phase<pg8::EpiBf16S, pg8::StaticOrder, PG8_ALIGN, PG8_SP2>(F.lds + RING_OFF, g, S, E);
        }
        SEAM(pb + 1);
        if (IN(pb + 2)) {
            const float* xin = (s == 0) ? args.in[0] : args.out;
            const float* gpost = (second ? args.in[19] : args.in[4]) + (size_t)l * D;
            const float* gnext = second ? (l + 1 < NL ? args.in[1] + (size_t)(l + 1) * D : nullptr) : args.in[5] + (size_t)l * D;
            norm_phase(F, xin, args.out, Fb, gpost, 0.5f, gnext, Hb);
        }
        SEAM(pb + 2);
        if (!second) {
            if (IN(pb + 3)) {
                pg8::Gemm g{Hb, (const bf16*)(wl + LW_WIN), M, NIN, D, D, D, 0}; pg8::StaticOrder S; S.init(M, NIN, F.G, (int)blockIdx.x);
                pg8::EpiInProj E{Pb, Ub, VT, SGA, SGB, M};
                pg8::gemm_phase<pg8::EpiInProj, pg8::StaticOrder, PG8_ALIGN, PG8_SP2>(F.lds + RING_OFF, g, S, E);
            }
            SEAM(pb + 3);
            if (IN(pb + 4)) {
                for (int u = F.vcu; u < M / 64; u += F.G) pool_unit(F, Pb, YZ, u);
                for (int u = F.vcu; u < 2 * (M / 128); u += F.G)
                    sgu_unit(F, VT, Ub, YZ, args.in[11] + (size_t)l * 8 * 16384, args.in[12] + (size_t)l * 8 * 128, args.in[10] + (size_t)l * SW, u);
            }
            SEAM(pb + 4);
            if (IN(pb + 5)) {
                pg8::Gemm g{YZ, (const bf16*)(wl + LW_WPS), M, D, 2048, 2048, 2048, 0}; pg8::StaticOrder S; S.init(M, D, F.G, (int)blockIdx.x);
                pg8::EpiGate E{SGA, SGB, MM};
                pg8::gemm_phase<pg8::EpiGate, pg8::StaticOrder, PG8_ALIGN, PG8_SP2>(F.lds + RING_OFF, g, S, E);
            }
            SEAM(pb + 5);
            if (IN(pb + 6)) {
                pg8::Gemm g{MM, (const bf16*)(wl + LW_WO), M, D, D, D, D, 0}; pg8::StaticOrder S; S.init(M, D, F.G, (int)blockIdx.x);
                pg8::EpiBf16S E{Fb, D, nullptr};
                pg8::gemm_phase<pg8::EpiBf16S, pg8::StaticOrder, PG8_ALIGN, PG8_SP2>(F.lds + RING_OFF, g, S, E);
            }
            SEAM(pb + 6);
            if (IN(pb + 7)) norm_phase(F, args.out, args.out, Fb, args.in[15] + (size_t)l * D, 1.0f, args.in[16] + (size_t)l * D, Hb);
            SEAM(pb + 7);
        }
    }
#undef IN
#undef SEAM
}

extern "C" void kernel_launch(void* const* d_in, const int* in_sizes, int n_in, void* d_out, int out_size, void* d_ws, size_t ws_size, hipStream_t stream) {
    static int grid = 0;
    if (grid == 0) {
        if (n_in != 20 || in_sizes[0] != M * D || out_size != M * D || ws_size < WS_END) { fprintf(stderr, "kernel_launch: shape/workspace mismatch: n_in %d in0 %d out %d ws %zu (need %zu)\n", n_in, n_in > 0 ? in_sizes[0] : -1, out_size, ws_size, (size_t)WS_END); grid = -1; return; }
        int dev = 0, cus = 0, per_cu = 0;
        if (hipGetDevice(&dev) != hipSuccess || hipDeviceGetAttribute(&cus, hipDeviceAttributeMultiprocessorCount, dev) != hipSuccess) { fprintf(stderr, "kernel_launch: device query failed\n"); grid = -1; return; }
        if (hipFuncSetAttribute((const void*)mk_fwd, hipFuncAttributeMaxDynamicSharedMemorySize, LDS_BYTES) != hipSuccess) { fprintf(stderr, "kernel_launch: hipFuncSetAttribute failed\n"); grid = -1; return; }
        if (hipOccupancyMaxActiveBlocksPerMultiprocessor(&per_cu, (const void*)mk_fwd, NWAVES * 64, LDS_BYTES) != hipSuccess || per_cu < 1) { fprintf(stderr, "kernel_launch: occupancy query reports %d workgroups per CU\n", per_cu); per_cu = 1; }
        (void)hipGetLastError();
        grid = cus;
    }
    if (grid < 0) return;
    if (hipMemsetAsync((char*)d_ws + WS_CTL, 0, CTL_ZERO_BYTES, stream) != hipSuccess) { fprintf(stderr, "kernel_launch: memset failed\n"); return; }
    Args a{};
    for (int i = 0; i < 20; ++i) a.in[i] = (const float*)d_in[i];
    a.out = (float*)d_out; a.ws = (unsigned char*)d_ws;
#if MK_ONE_LAUNCH
    a.ph_lo = 0; a.ph_hi = N_PHASES;
    hipLaunchKernelGGL(mk_fwd, dim3(grid), dim3(NWAVES * 64), LDS_BYTES, stream, a);
#else
    for (int p = 0; p < N_PHASES; ++p) { a.ph_lo = p; a.ph_hi = p + 1; hipLaunchKernelGGL(mk_fwd, dim3(grid), dim3(NWAVES * 64), LDS_BYTES, stream, a); }
#endif
    const hipError_t le = hipPeekAtLastError();
    if (le != hipSuccess) fprintf(stderr, "kernel_launch: launch failed: %s\n", hipGetErrorName(le));
}
```

```cpp
#include <hip/hip_runtime.h>
#include <cstdio>
#include <cstdint>

#ifndef MK_ONE_LAUNCH
#define MK_ONE_LAUNCH 1
#endif

namespace pg8 {
#define PG8_LAS __attribute__((address_space(3)))
typedef unsigned short bf16_t;
typedef short bf16x8 __attribute__((ext_vector_type(8)));
typedef float f32x4 __attribute__((ext_vector_type(4)));
typedef float f32x2 __attribute__((ext_vector_type(2)));
typedef unsigned u32x4 __attribute__((ext_vector_type(4)));
typedef unsigned u32x2 __attribute__((ext_vector_type(2)));
constexpr int BM = 256, BK = 64, HALF = 128, HTB = HALF * BK * 2  , STAGE_BYTES = 8 * HTB, NXCD = 8, WGM = 8;

__host__ __device__ __forceinline__ int lds_byte(int r, int c) { const int st = (r >> 4) * 2 + (c >> 5), rr = r & 15, cc = c & 31, ob = rr * 64 + cc * 2; return st * 1024 + (ob ^ (((ob >> 9) & 1) << 5)); }
__host__ __device__ __forceinline__ void stage_rc(int b, int& R, int& C) { const int st = b / 1024, sb = b % 1024, swz = sb ^ (((sb >> 9) & 1) << 5); R = (st >> 1) * 16 + swz / 64; C = (st & 1) * 32 + (swz % 64) / 2; }
__host__ __device__ __forceinline__ int perm32(int rho) { const int n = rho >> 4, i = rho & 15; return 8 * (i >> 2) + 4 * n + (i & 3); }

struct Unit { int pm, pn; };
struct Gemm { const bf16_t* A; const bf16_t* Bt; int M, N, K, lda, ldb, a_pn_koff; };

struct StaticOrder {
    int nM, nN, nwg, G, c;
    __host__ __device__ void init(int M, int N, int G_, int c_) { nM = M / BM; nN = N / BM; nwg = nM * nN; G = G_; c = c_; }
    __host__ __device__ bool next(int i, Unit& u) const {
        const long L = (long)i * G + c; if (L >= nwg) return false;
        int wgid = (int)L; { const int q = nwg / NXCD, r = nwg % NXCD, xcd = wgid % NXCD, off = wgid / NXCD; wgid = (xcd < r ? xcd * (q + 1) : r * (q + 1) + (xcd - r) * q) + off; }
        const int nig = WGM * nN, gid = wgid / nig, fm = gid * WGM, gsz = (nM - fm) < WGM ? (nM - fm) : WGM;
        u.pm = fm + ((wgid % nig) % gsz); u.pn = (wgid % nig) / gsz; return true;
    }
    __device__ __forceinline__ void a_ready(const Unit&) const {}
    __device__ __forceinline__ void done(const Unit&) const {}
};

__device__ __forceinline__ unsigned cvt_pk_bf16(float lo, float hi) { unsigned r; asm volatile("v_cvt_pk_bf16_f32 %0, %1, %2" : "=v"(r) : "v"(lo), "v"(hi)); return r; }
__device__ __forceinline__ float bf_lo(unsigned w) { return __uint_as_float(w << 16); }
__device__ __forceinline__ float bf_hi(unsigned w) { return __uint_as_float(w & 0xffff0000u); }
__device__ __forceinline__ float sigmoid_f(float x) { return __builtin_amdgcn_rcpf(1.0f + __builtin_amdgcn_exp2f(-1.4426950408889634f * x)); }
__device__ __forceinline__ float silu_f(float x) { return x * sigmoid_f(x); }
__device__ __forceinline__ float gelu_f(float x) { const float y = 1.5957691216057308f * (x + 0.044715f * x * x * x); return x * sigmoid_f(y); }
__device__ __forceinline__ u32x4 pack8(const f32x4 v0, const f32x4 v1) { u32x4 w; w.x = cvt_pk_bf16(v0[0], v0[1]); w.y = cvt_pk_bf16(v0[2], v0[3]); w.z = cvt_pk_bf16(v1[0], v1[1]); w.w = cvt_pk_bf16(v1[2], v1[3]); return w; }

struct EpiSwiGLU {
    static constexpr bool PERM = true, AFTER_DRAIN = false, SWAP = false, MID = false;
    bf16_t* O; int ldc;
    __device__ __forceinline__ bool swapped(const Unit&) const { return false; }
    __device__ __forceinline__ void mid(f32x4 (&)[2][2][4][2], const Unit&, int, int, int, int) const {}
    __device__ __forceinline__ void operator()(const f32x4 (&acc)[2][2][4][2], const Unit& u, int wr, int wc, int fr, int fq) const {
        const int row0 = u.pm * BM + wr * 64 + fr, col0 = u.pn * HALF + wc * 32 + 8 * fq;
#pragma unroll
        for (int ai = 0; ai < 2; ++ai)
#pragma unroll
            for (int m = 0; m < 4; ++m) { bf16_t* rowp = O + (size_t)(row0 + ai * HALF + m * 16) * ldc + col0;
                f32x4 v0, v1;
#pragma unroll
                for (int j = 0; j < 4; ++j) { v0[j] = silu_f(acc[ai][0][m][0][j]) * acc[ai][1][m][0][j]; v1[j] = silu_f(acc[ai][0][m][1][j]) * acc[ai][1][m][1][j]; }
                *(u32x4*)rowp = pack8(v0, v1); }
    }
};
struct EpiBf16S {
    static constexpr bool PERM = true, AFTER_DRAIN = false, SWAP = false, MID = false;
    bf16_t* O; int ldc; const float* scale;
    __device__ __forceinline__ bool swapped(const Unit&) const { return false; }
    __device__ __forceinline__ void mid(f32x4 (&)[2][2][4][2], const Unit&, int, int, int, int) const {}
    __device__ __forceinline__ void operator()(const f32x4 (&acc)[2][2][4][2], const Unit& u, int wr, int wc, int fr, int fq) const {
        const int row0 = u.pm * BM + wr * 64 + fr, col0 = u.pn * BM + wc * 32 + 8 * fq;
        f32x4 sv[2][2];
#pragma unroll
        for (int bj = 0; bj < 2; ++bj)
#pragma unroll
            for (int n = 0; n < 2; ++n) sv[bj][n] = scale ? *(const f32x4*)(scale + col0 + bj * HALF + 4 * n) : (f32x4){1.f, 1.f, 1.f, 1.f};
#pragma unroll
        for (int ai = 0; ai < 2; ++ai)
#pragma unroll
            for (int m = 0; m < 4; ++m) { bf16_t* rowp = O + (size_t)(row0 + ai * HALF + m * 16) * ldc + col0;
#pragma unroll
                for (int bj = 0; bj < 2; ++bj) *(u32x4*)(rowp + bj * HALF) = pack8(acc[ai][bj][m][0] * sv[bj][0], acc[ai][bj][m][1] * sv[bj][1]); }
    }
};
struct EpiInProj {
    static constexpr bool PERM = true, AFTER_DRAIN = false, SWAP = true, MID = false;
    bf16_t *P, *U, *VT, *SGA, *SGB; int Mrows;
    __device__ __forceinline__ bool swapped(const Unit& u) const { return u.pn >= 8 && u.pn < 12; }
    __device__ __forceinline__ void mid(f32x4 (&)[2][2][4][2], const Unit&, int, int, int, int) const {}
    __device__ __forceinline__ void operator()(const f32x4 (&acc)[2][2][4][2], const Unit& u, int wr, int wc, int fr, int fq) const {
        bf16_t* base; int ldc, rbase, cbase, act;
        if (u.pn < 4)       { base = P;   ldc = 1024;  rbase = u.pm * BM;       cbase = u.pn * BM;        act = 0; }
        else if (u.pn < 8)  { base = U;   ldc = 1024;  rbase = u.pm * BM;       cbase = (u.pn - 4) * BM;  act = 1; }
        else if (u.pn < 12) { base = VT;  ldc = Mrows; rbase = (u.pn - 8) * BM; cbase = u.pm * BM;        act = 1; }
        else if (u.pn < 20) { base = SGA; ldc = 2048;  rbase = u.pm * BM;       cbase = (u.pn - 12) * BM; act = 2; }
        else                { base = SGB; ldc = 2048;  rbase = u.pm * BM;       cbase = (u.pn - 20) * BM; act = 2; }
        const int row0 = rbase + wr * 64 + fr, col0 = cbase + wc * 32 + 8 * fq;
#pragma unroll
        for (int ai = 0; ai < 2; ++ai)
#pragma unroll
            for (int m = 0; m < 4; ++m) { bf16_t* rowp = base + (size_t)(row0 + ai * HALF + m * 16) * ldc + col0;
#pragma unroll
                for (int bj = 0; bj < 2; ++bj) { f32x4 v0 = acc[ai][bj][m][0], v1 = acc[ai][bj][m][1];
                    if (act == 1) {
#pragma unroll
                        for (int j = 0; j < 4; ++j) { v0[j] = gelu_f(v0[j]); v1[j] = gelu_f(v1[j]); } }
                    else if (act == 2) {
#pragma unroll
                        for (int j = 0; j < 4; ++j) { v0[j] = sigmoid_f(v0[j]); v1[j] = sigmoid_f(v1[j]); } }
                    *(u32x4*)(rowp + bj * HALF) = pack8(v0, v1); } }
    }
};
struct EpiGate {
    static constexpr bool PERM = true, AFTER_DRAIN = false, SWAP = false, MID = true;
    const bf16_t *SGA, *SGB; bf16_t* O;
    __device__ __forceinline__ bool swapped(const Unit&) const { return false; }
    __device__ __forceinline__ void mid(f32x4 (&acc)[2][2][4][2], const Unit& u, int wr, int wc, int fr, int fq) const {
        const int row0 = u.pm * BM + wr * 64 + fr, col0 = u.pn * BM + wc * 32 + 8 * fq;
#pragma unroll
        for (int ai = 0; ai < 2; ++ai)
#pragma unroll
            for (int m = 0; m < 4; ++m) { const size_t off = (size_t)(row0 + ai * HALF + m * 16) * 2048 + col0;
#pragma unroll
                for (int bj = 0; bj < 2; ++bj) { const u32x4 a = *(const u32x4*)(SGA + off + bj * HALF), b = *(const u32x4*)(SGB + off + bj * HALF);
#pragma unroll
                    for (int k = 0; k < 4; ++k) { const float rl = bf_lo(a[k]) * __builtin_amdgcn_rcpf(fmaxf(bf_lo(b[k]), 1e-30f)), rh = bf_hi(a[k]) * __builtin_amdgcn_rcpf(fmaxf(bf_hi(b[k]), 1e-30f));
                        acc[ai][bj][m][k >> 1][(k & 1) * 2] *= rl; acc[ai][bj][m][k >> 1][(k & 1) * 2 + 1] *= rh; } } }
    }
    __device__ __forceinline__ void operator()(const f32x4 (&acc)[2][2][4][2], const Unit& u, int wr, int wc, int fr, int fq) const {
        const int row0 = u.pm * BM + wr * 64 + fr, col0 = u.pn * BM + wc * 32 + 8 * fq;
#pragma unroll
        for (int ai = 0; ai < 2; ++ai)
#pragma unroll
            for (int m = 0; m < 4; ++m) { const size_t off = (size_t)(row0 + ai * HALF + m * 16) * 2048 + col0;
#pragma unroll
                for (int bj = 0; bj < 2; ++bj) { const u32x4 b = *(const u32x4*)(SGB + off + bj * HALF);
                    const f32x4 s0 = {fmaxf(bf_lo(b[0]), 1e-30f), fmaxf(bf_hi(b[0]), 1e-30f), fmaxf(bf_lo(b[1]), 1e-30f), fmaxf(bf_hi(b[1]), 1e-30f)};
                    const f32x4 s1 = {fmaxf(bf_lo(b[2]), 1e-30f), fmaxf(bf_hi(b[2]), 1e-30f), fmaxf(bf_lo(b[3]), 1e-30f), fmaxf(bf_hi(b[3]), 1e-30f)};
                    *(u32x4*)(O + off + bj * HALF) = pack8(acc[ai][bj][m][0] * s0, acc[ai][bj][m][1] * s1); } }
    }
};

template <class Epi, class Sched, bool ALIGN_EPI = false, bool SP2 = false>
__device__ __forceinline__ void gemm_phase(PG8_LAS unsigned char* lds, const Gemm g, const Sched& S, const Epi& E) {
    int tid = threadIdx.x; asm volatile("" : "+v"(tid));
    const int wid = __builtin_amdgcn_readfirstlane(tid >> 6), lane = tid & 63, wr = wid >> 2, wc = wid & 3, fr = lane & 15, fq = lane >> 4;
    const int K = g.K, nt = K / BK;
    unsigned voffA[2], voffB[2];
#pragma unroll
    for (int i = 0; i < 2; ++i) { int R, C; stage_rc(tid * 16 + i * 8192, R, C); const int Rb = Epi::PERM ? ((R & ~31) + perm32(R & 31)) : R;
        voffA[i] = (unsigned)(R * g.lda + C) * 2u; voffB[i] = (unsigned)(Rb * g.ldb + C) * 2u; }
    const size_t kstep = (size_t)(BK * 2);
    const size_t hstepA = (size_t)HALF * g.lda * 2, hstepB = (size_t)HALF * g.ldb * 2;
    const size_t tstepA = 2 * hstepA, tstepB = 2 * hstepB;
    const unsigned ldsw = (unsigned)wid * 1024u;
    const int aoff = lds_byte(wr * 64 + fr, fq * 8), boff = lds_byte(wc * 32 + fr, fq * 8);
#define PG8_SA(b, h) (((b) * 2 + (h)) * HTB)
#define PG8_SB(b, h) ((4 + (b) * 2 + (h)) * HTB)
#define PG8_STAGE(bufoff, gbase, voff) do { _Pragma("unroll") for (int _i = 0; _i < 2; ++_i) \
        __builtin_amdgcn_global_load_lds((const unsigned*)((const char*)(gbase) + (voff)[_i]), (PG8_LAS unsigned*)(lds + (bufoff) + ldsw + _i * 8192), 16, 0, 0); } while (0)
#define PG8_LDA(dst, b, h) do { _Pragma("unroll") for (int m = 0; m < 4; ++m) _Pragma("unroll") for (int k = 0; k < 2; ++k) dst[m][k] = *(const PG8_LAS bf16x8*)(lds + PG8_SA(b, h) + aoff + m * 2048 + k * 1024); } while (0)
#define PG8_LDB(dst, b, h) do { _Pragma("unroll") for (int n = 0; n < 2; ++n) _Pragma("unroll") for (int k = 0; k < 2; ++k) dst[n][k] = *(const PG8_LAS bf16x8*)(lds + PG8_SB(b, h) + boff + n * 2048 + k * 1024); } while (0)
#define PG8_MMA(ai, bj, At, Bt) do { __builtin_amdgcn_s_setprio(1); _Pragma("unroll") for (int m = 0; m < 4; ++m) _Pragma("unroll") for (int n = 0; n < 2; ++n) _Pragma("unroll") for (int k = 0; k < 2; ++k) \
        acc[ai][bj][m][n] = __builtin_amdgcn_mfma_f32_16x16x32_bf16(Bt[n][k], At[m][k], acc[ai][bj][m][n], 0, 0, 0); __builtin_amdgcn_s_setprio(0); } while (0)
#define PG8_WAIT_V(n) asm volatile("s_waitcnt vmcnt(" #n ")" ::: "memory")
#define PG8_WAIT_L(n) asm volatile("s_waitcnt lgkmcnt(" #n ")" ::: "memory")
#define PG8_BAR __builtin_amdgcn_s_barrier()
#define PG8_SCHED __builtin_amdgcn_sched_barrier(0)
#define PG8_UNIT_PTRS(u, pa, pb) do { const char* _a = (const char*)g.A + (size_t)(u).pm * tstepA + (size_t)(u).pn * (size_t)g.a_pn_koff * 2; const char* _b = (const char*)g.Bt + (size_t)(u).pn * tstepB; \
        if (Epi::SWAP && E.swapped(u)) { pa = _b; pb = _a; } else { pa = _a; pb = _b; } } while (0)
    Unit cur, nxt; int ui = 0;
    if (!S.next(0, cur)) return;
    f32x4 acc[2][2][4][2];
#pragma unroll
    for (int a = 0; a < 2; ++a)
#pragma unroll
        for (int b = 0; b < 2; ++b)
#pragma unroll
            for (int m = 0; m < 4; ++m)
#pragma unroll
                for (int n = 0; n < 2; ++n) acc[a][b][m][n] = (f32x4){0.f, 0.f, 0.f, 0.f};
    bf16x8 At[4][2], B0[2][2], B1[2][2];
    const char* cA; const char* cB; PG8_UNIT_PTRS(cur, cA, cB);
    S.a_ready(cur);
    if constexpr (SP2) {
        PG8_STAGE(PG8_SB(0, 0), cB, voffB); PG8_STAGE(PG8_SB(0, 1), cB + hstepB, voffB); PG8_STAGE(PG8_SA(0, 0), cA, voffA); PG8_STAGE(PG8_SA(0, 1), cA + hstepA, voffA);
        if (wr == 1) PG8_BAR;
        PG8_WAIT_V(2); PG8_BAR;
        PG8_STAGE(PG8_SB(1, 0), cB + kstep, voffB); PG8_STAGE(PG8_SA(1, 0), cA + kstep, voffA); PG8_STAGE(PG8_SB(1, 1), cB + hstepB + kstep, voffB);
        PG8_WAIT_V(6); PG8_BAR;
    } else {
        PG8_STAGE(PG8_SB(0, 0), cB, voffB); PG8_STAGE(PG8_SA(0, 0), cA, voffA); PG8_STAGE(PG8_SB(0, 1), cB + hstepB, voffB); PG8_STAGE(PG8_SA(0, 1), cA + hstepA, voffA);
        if (wr == 1) PG8_BAR;
        PG8_WAIT_V(4); PG8_BAR;
        PG8_STAGE(PG8_SB(1, 0), cB + kstep, voffB); PG8_STAGE(PG8_SA(1, 0), cA + kstep, voffA); PG8_STAGE(PG8_SB(1, 1), cB + hstepB + kstep, voffB);
        PG8_WAIT_V(6); PG8_BAR;
    }
    for (;;) {
        const bool has_next = S.next(ui + 1, nxt);
        const char* nA = cA; const char* nB = cB; if (has_next) PG8_UNIT_PTRS(nxt, nA, nB);
        for (int t = 0; t < nt; t += 2) {
            const bool last = (t == nt - 2);
            const char* a1 = cA + (size_t)(t + 1) * kstep;
            const char* a2 = last ? nA : cA + (size_t)(t + 2) * kstep; const char* b2 = last ? nB : cB + (size_t)(t + 2) * kstep;
            const char* a3 = a2 + kstep; const char* b3 = b2 + kstep;
            if (last && has_next) S.a_ready(nxt);
            if constexpr (Epi::MID) { if (t == (nt >> 1)) { int tz = threadIdx.x; asm volatile("" : "+v"(tz)); const int w2 = __builtin_amdgcn_readfirstlane(tz >> 6), l2 = tz & 63; E.mid(acc, cur, w2 >> 2, w2 & 3, l2 & 15, l2 >> 4); } }
            if constexpr (SP2) {
            PG8_LDB(B0, 0, 0); PG8_LDB(B1, 0, 1); PG8_SCHED; PG8_LDA(At, 0, 0); PG8_STAGE(PG8_SA(1, 1), a1 + hstepA, voffA);
            PG8_WAIT_V(8); PG8_WAIT_L(0); PG8_BAR; PG8_MMA(0, 0, At, B0); PG8_MMA(0, 1, At, B1); PG8_BAR; PG8_SCHED;
            PG8_LDA(At, 0, 1); PG8_STAGE(PG8_SB(0, 0), b2, voffB); PG8_STAGE(PG8_SB(0, 1), b2 + hstepB, voffB); PG8_STAGE(PG8_SA(0, 0), a2, voffA);
            PG8_WAIT_V(8); PG8_WAIT_L(0); PG8_BAR; PG8_MMA(1, 0, At, B0); PG8_MMA(1, 1, At, B1); PG8_BAR; PG8_SCHED;
            PG8_LDB(B0, 1, 0); PG8_LDB(B1, 1, 1); PG8_SCHED; PG8_LDA(At, 1, 0); PG8_STAGE(PG8_SA(0, 1), a2 + hstepA, voffA);
            PG8_WAIT_V(8); PG8_WAIT_L(0); PG8_BAR; PG8_MMA(0, 0, At, B0); PG8_MMA(0, 1, At, B1); PG8_BAR; PG8_SCHED;
            PG8_LDA(At, 1, 1); PG8_STAGE(PG8_SB(1, 0), b3, voffB); PG8_STAGE(PG8_SB(1, 1), b3 + hstepB, voffB); PG8_STAGE(PG8_SA(1, 0), a3, voffA);
            PG8_WAIT_V(8); PG8_WAIT_L(0); PG8_BAR; PG8_MMA(1, 0, At, B0); PG8_MMA(1, 1, At, B1); PG8_BAR; PG8_SCHED;
            } else {
            PG8_LDB(B0, 0, 0); PG8_SCHED; PG8_LDA(At, 0, 0); PG8_STAGE(PG8_SA(1, 1), a1 + hstepA, voffA);
            PG8_WAIT_L(8); PG8_BAR; PG8_WAIT_L(0); PG8_MMA(0, 0, At, B0); PG8_BAR; PG8_SCHED;
            PG8_LDB(B1, 0, 1); PG8_STAGE(PG8_SB(0, 0), b2, voffB);
            PG8_BAR; PG8_WAIT_L(0); PG8_MMA(0, 1, At, B1); PG8_BAR;
            PG8_LDA(At, 0, 1); PG8_STAGE(PG8_SA(0, 0), a2, voffA);
            PG8_BAR; PG8_WAIT_L(0); PG8_MMA(1, 0, At, B0); PG8_BAR; PG8_SCHED;
            PG8_STAGE(PG8_SB(0, 1), b2 + hstepB, voffB);
            PG8_WAIT_V(6); PG8_BAR; PG8_MMA(1, 1, At, B1); PG8_BAR;
            PG8_LDB(B0, 1, 0); PG8_SCHED; PG8_LDA(At, 1, 0); PG8_STAGE(PG8_SA(0, 1), a2 + hstepA, voffA);
            PG8_WAIT_L(8); PG8_BAR; PG8_WAIT_L(0); PG8_MMA(0, 0, At, B0); PG8_BAR; PG8_SCHED;
            PG8_LDB(B1, 1, 1); PG8_STAGE(PG8_SB(1, 0), b3, voffB);
            PG8_BAR; PG8_WAIT_L(0); PG8_MMA(0, 1, At, B1); PG8_BAR;
            PG8_LDA(At, 1, 1); PG8_STAGE(PG8_SA(1, 0), a3, voffA);
            PG8_BAR; PG8_WAIT_L(0); PG8_MMA(1, 0, At, B0); PG8_BAR; PG8_SCHED;
            PG8_STAGE(PG8_SB(1, 1), b3 + hstepB, voffB);
            PG8_WAIT_V(6); PG8_BAR; PG8_MMA(1, 1, At, B1); PG8_BAR;
            }
        }
        if constexpr (ALIGN_EPI) { if (wr == 0) PG8_BAR; }
        { int tz = threadIdx.x; asm volatile("" : "+v"(tz)); const int w2 = __builtin_amdgcn_readfirstlane(tz >> 6), l2 = tz & 63; E(acc, cur, w2 >> 2, w2 & 3, l2 & 15, l2 >> 4); }
        S.done(cur);
        if (!has_next) break;
#pragma unroll
        for (int a = 0; a < 2; ++a)
#pragma unroll
            for (int b = 0; b < 2; ++b)
#pragma unroll
                for (int m = 0; m < 4; ++m)
#pragma unroll
                    for (int n = 0; n < 2; ++n) acc[a][b][m][n] = (f32x4){0.f, 0.f, 0.f, 0.f};
        cur = nxt; cA = nA; cB = nB; ++ui;
        if constexpr (ALIGN_EPI) { if (wr == 1) PG8_BAR; }
    }
    PG8_WAIT_V(0);
    if constexpr (!ALIGN_EPI) { if (wr == 0) PG8_BAR; }
    PG8_BAR;
#undef PG8_SA
#undef PG8_SB
#undef PG8_STAGE
#undef PG8_LDA
#undef PG8_LDB
#undef PG8_MMA
#undef PG8_WAIT_V
#undef PG8_WAIT_L
#undef PG8_BAR
#undef PG8_SCHED
#undef PG8_UNIT_PTRS
}
}

constexpr int NWAVES = 8;
constexpr int BATCH = 4, SEQ = 4096, D = 2048, FF = 5632, NUP = 2 * FF, NIN = 7168, PW = 1024, SW = 1024, NL = 4;
constexpr int M = BATCH * SEQ;
constexpr float EPS = 1e-6f;
constexpr int N_PHASES = 2 + 11 * NL;

constexpr size_t MiB = 1u << 20;
constexpr size_t WS_CTL = 0, CTL_ZERO_BYTES = 1 * MiB;
constexpr size_t WS_W = 2 * MiB;
constexpr size_t LW_UP1 = 0, LW_DN1 = 44 * MiB, LW_WIN = 66 * MiB, LW_WG = 94 * MiB, LW_WPS = 94 * MiB + MiB / 2, LW_WO = 102 * MiB + MiB / 2, LW_UP2 = 110 * MiB + MiB / 2, LW_DN2 = 154 * MiB + MiB / 2;
constexpr size_t LW_STRIDE = 176 * MiB + MiB / 2;
static_assert((size_t)NUP * D * 2 == 44 * MiB && (size_t)D * FF * 2 == 22 * MiB && (size_t)NIN * D * 2 == 28 * MiB && (size_t)1024 * 256 * 2 == MiB / 2 && (size_t)D * D * 2 == 8 * MiB, "weight sizes");
constexpr size_t WS_H = WS_W + NL * LW_STRIDE;
constexpr size_t WS_F = WS_H + 64 * MiB;
constexpr size_t WS_R = WS_F + 64 * MiB;
constexpr size_t WS_P = WS_R, WS_U = WS_R + 32 * MiB, WS_VT = WS_R + 64 * MiB, WS_P1 = WS_R + 96 * MiB, WS_SGA = WS_R + 128 * MiB, WS_SGB = WS_R + 192 * MiB, WS_YZ = WS_R + 256 * MiB, WS_MM = WS_R + 320 * MiB;
constexpr size_t WS_ACT = WS_R + 384 * MiB;
constexpr size_t WS_END = WS_ACT + 176 * MiB;
constexpr size_t WS_TPO = WS_R, WS_TGS = WS_R + 16 * MiB;
static_assert((size_t)M * FF * 2 == 176 * MiB && WS_H == 708 * MiB, "ws map");
constexpr int CW_BAR = 4096, CW_QUAD = 8192;

constexpr int RING_OFF = 0, RING_BYTES = 131072;
constexpr int LDSCTL_OFF = RING_BYTES, MISC_OFF = LDSCTL_OFF + 320;
constexpr int LDS_BYTES = 147456;
static_assert(MISC_OFF + 128 <= LDS_BYTES, "LDS map");

#define GAS __attribute__((address_space(1)))
#define LAS __attribute__((address_space(3)))
typedef unsigned short bf16;
typedef unsigned v4u __attribute__((ext_vector_type(4)));
typedef unsigned v2u __attribute__((ext_vector_type(2)));
typedef float f32x4 __attribute__((ext_vector_type(4)));
typedef short bf16x8 __attribute__((ext_vector_type(8)));
typedef GAS unsigned gu32;
#define RLX_AGENT __ATOMIC_RELAXED, __HIP_MEMORY_SCOPE_AGENT
#define LDS_WAIT() asm volatile("s_waitcnt lgkmcnt(0)" ::: "memory")
#define VM_WAIT() asm volatile("s_waitcnt vmcnt(0)" ::: "memory")
__device__ __forceinline__ unsigned f2bf(float f) { unsigned u = __builtin_bit_cast(unsigned, f); return (u + 0x7fffu + ((u >> 16) & 1u)) >> 16; }
__device__ __forceinline__ unsigned pk2(float lo, float hi) { return f2bf(lo) | (f2bf(hi) << 16); }
__device__ __forceinline__ float bflo(unsigned w) { return __uint_as_float(w << 16); }
__device__ __forceinline__ float bfhi(unsigned w) { return __uint_as_float(w & 0xffff0000u); }

#define XB_TMO      128
#define XB_XCNT(j)  (256  + 64 * (j))
#define XB_XSUB(j)  (1280 + 64 * (j))
#define XB_XGEN(j)  (2304 + 64 * (j))
#define XB_TOP      3328
#define XB_TOPGEN   3392
#define XCD_BAR_WORDS 3456
#define XB_SPIN_CAP (1u << 18)

__device__ __forceinline__ unsigned xb_ld(unsigned* p)              { return __hip_atomic_load(p, __ATOMIC_RELAXED, __HIP_MEMORY_SCOPE_AGENT); }
__device__ __forceinline__ unsigned xb_add(unsigned* p, unsigned v) { return __hip_atomic_fetch_add(p, v, __ATOMIC_RELAXED, __HIP_MEMORY_SCOPE_AGENT); }
__device__ __forceinline__ unsigned xb_xcc_id() { return (unsigned)__builtin_amdgcn_s_getreg((3 << 11) | 20) & 0xFu; }
#define XB_SPIN(cond, bar) do { unsigned _sp = 0; while (cond) { __builtin_amdgcn_s_sleep(1); \
    if ((++_sp & 255u) == 0u) { if (xb_ld(&(bar)[XB_TMO])) break; if (_sp > XB_SPIN_CAP) { atomicAdd(&(bar)[XB_TMO], 1u); break; } } } } while (0)

struct XcdBarrier {
    unsigned* bar; unsigned x;
    volatile LAS unsigned* st;
};
__device__ __forceinline__ XcdBarrier xcd_barrier_post(unsigned* bar, volatile LAS unsigned* st) {
    XcdBarrier b; b.bar = bar; b.x = xb_xcc_id(); b.st = st;
    if (threadIdx.x == 0) st[2] = xb_add(&bar[XB_XCNT(b.x)], 1u);
    return b;
}
__device__ __forceinline__ void xcd_barrier_complete(unsigned* bar, unsigned x, unsigned& nloc, unsigned& nx, unsigned& uni) {
    const unsigned G = gridDim.x * gridDim.y * gridDim.z;
    unsigned sum, cnt, mine, sp = 0u;
    for (;;) {
        sum = 0u; cnt = 0u; mine = 0u; uni = 1u;
#pragma unroll
        for (unsigned j = 0; j < 16; ++j) { const unsigned c = xb_ld(&bar[XB_XCNT(j)]); sum += c; cnt += (c > 0u) ? 1u : 0u; mine = (j == x) ? c : mine; if (c != (j < 8u ? 32u : 0u)) uni = 0u; }
        if (sum == G) break;
        __builtin_amdgcn_s_sleep(1);
        if ((++sp & 255u) == 0u) { if (xb_ld(&bar[XB_TMO])) break; if (sp > XB_SPIN_CAP) { atomicAdd(&bar[XB_TMO], 1u); break; } }
    }
    nloc = mine > 0u ? mine : 1u; nx = cnt > 0u ? cnt : 1u; if (sum != G) uni = 0u;
}
__device__ __forceinline__ void xcd_barrier(const XcdBarrier& b, const bool local) {
    asm volatile("s_waitcnt vmcnt(0)" ::: "memory");
    __syncthreads();
    if (threadIdx.x == 0) {
        unsigned* bar = b.bar;
        __builtin_amdgcn_s_waitcnt(0);
        unsigned nloc = b.st[0], nx = b.st[1];
        if (nloc == 0u) { unsigned uni; xcd_barrier_complete(bar, b.x, nloc, nx, uni); b.st[0] = nloc; b.st[1] = nx; b.st[3] = uni; }
        const unsigned old = xb_add(&bar[XB_XSUB(b.x)], 1u);
        const unsigned gen = old / nloc;
        if (old + 1u == (gen + 1u) * nloc) {
            __builtin_amdgcn_fence(__ATOMIC_RELEASE, "agent");
            asm volatile("s_waitcnt vmcnt(0)" ::: "memory");
            if (!local) {
            const unsigned og = xb_add(&bar[XB_TOP], 1u);
            const unsigned tg = og / nx;
            if (og + 1u == (tg + 1u) * nx) xb_add(&bar[XB_TOPGEN], 1u);
            else XB_SPIN(xb_ld(&bar[XB_TOPGEN]) == tg, bar);
            }
            __builtin_amdgcn_fence(__ATOMIC_ACQUIRE, "agent");
            xb_add(&bar[XB_XGEN(b.x)], 1u);
            asm volatile("s_waitcnt vmcnt(0)" ::: "memory");
        } else {
            XB_SPIN(xb_ld(&bar[XB_XGEN(b.x)]) == gen, bar);
            __builtin_amdgcn_fence(__ATOMIC_ACQUIRE, "agent");
            asm volatile("s_waitcnt vmcnt(0)" ::: "memory");
        }
    }
    __syncthreads();
}

__device__ __forceinline__ void quad_barrier(unsigned* cnt, unsigned* tmo) {
    asm volatile("s_waitcnt vmcnt(0)" ::: "memory");
    __syncthreads();
    if (threadIdx.x == 0) {
        __builtin_amdgcn_s_waitcnt(0);
        const unsigned old = xb_add(cnt, 1u), target = (old / 4u + 1u) * 4u;
        unsigned sp = 0;
        while (xb_ld(cnt) < target) { __builtin_amdgcn_s_sleep(1); if ((++sp & 255u) == 0u) { if (xb_ld(tmo)) break; if (sp > XB_SPIN_CAP) { atomicAdd(tmo, 1u); break; } } }
        __builtin_amdgcn_fence(__ATOMIC_ACQUIRE, "agent");
        asm volatile("s_waitcnt vmcnt(0)" ::: "memory");
    }
    __syncthreads();
}

struct Frame {
    LAS unsigned char* lds;
    volatile LAS unsigned* MISC;
    gu32* ctl;
    int vcu, G;
    int gx, gr, grp;
};
struct Lane { int tid, lane, wave; };
__device__ __forceinline__ Lane opaque_lane() { int t = threadIdx.x; asm volatile("" : "+v"(t)); Lane q; q.tid = t; q.lane = t & 63; q.wave = __builtin_amdgcn_readfirstlane(t >> 6); return q; }
__device__ __forceinline__ float wave_sum(float v) {
#pragma unroll
    for (int o = 1; o < 64; o <<= 1) v += __shfl_xor(v, o);
    return v;
}

__device__ __forceinline__ void p0_transpose_item(const float* W, int Ns, bf16* WT, int dld, int koff, int mode, LAS float* scr, int item, int lane) {
    const int nblk = Ns / 32, kb = item / nblk, nb = item % nblk, k0 = 64 * kb, n0 = 32 * nb;
    const int n0s = mode ? (((n0 >> 7) & 1) * FF + (n0 >> 8) * 128 + (n0 & 127)) : n0;
#pragma unroll 8
    for (int i = 0; i < 32; ++i) { const int kk = 2 * i + (lane >> 5); scr[kk * 33 + (lane & 31)] = W[(size_t)(k0 + kk) * Ns + n0s + (lane & 31)]; }
    LDS_WAIT(); asm volatile("" ::: "memory");
    const int c = lane & 7;
#pragma unroll
    for (int j = 0; j < 4; ++j) { const int n = (lane >> 3) + 8 * j; const LAS float* s = scr + (8 * c) * 33 + n;
        v4u o; o.x = pk2(s[0 * 33], s[1 * 33]); o.y = pk2(s[2 * 33], s[3 * 33]); o.z = pk2(s[4 * 33], s[5 * 33]); o.w = pk2(s[6 * 33], s[7 * 33]);
        *(v4u*)(WT + (size_t)(n0 + n) * dld + koff + k0 + 8 * c) = o; }
    LDS_WAIT(); asm volatile("" ::: "memory");
}

struct Args { const float* in[20]; float* out; unsigned char* ws; int ph_lo, ph_hi; };

__device__ __forceinline__ void p0_prologue(Frame& F, const Args& args) {
    const Lane T = opaque_lane();
    LAS float* scr = (LAS float*)(F.lds + RING_OFF + T.wave * 16384);
    const int gw = F.vcu * NWAVES + T.wave, NGW = F.G * NWAVES;
    constexpr int I_UP = (D / 64) * (NUP / 32), I_DN = (FF / 64) * (D / 32), I_IN = (D / 64) * (NIN / 32), I_G = 4 * 256 * 256 / 2048, I_PO = (PW / 64) * (D / 32), I_SO = I_PO, I_O = (D / 64) * (D / 32);
    constexpr int PER_LAYER = 2 * I_UP + 2 * I_DN + I_IN + I_G + I_PO + I_SO + I_O;
    constexpr int NITEMS = NL * PER_LAYER;
    for (int it = gw; it < NITEMS; it += NGW) {
        const int l = it / PER_LAYER; int r = it % PER_LAYER;
        unsigned char* wl = args.ws + WS_W + (size_t)l * LW_STRIDE;
        if (r < I_UP) { p0_transpose_item(args.in[2] + (size_t)l * D * NUP, NUP, (bf16*)(wl + LW_UP1), D, 0, 1, scr, r, T.lane); continue; } r -= I_UP;
        if (r < I_DN) { p0_transpose_item(args.in[3] + (size_t)l * FF * D, D, (bf16*)(wl + LW_DN1), FF, 0, 0, scr, r, T.lane); continue; } r -= I_DN;
        if (r < I_IN) { p0_transpose_item(args.in[6] + (size_t)l * D * NIN, NIN, (bf16*)(wl + LW_WIN), D, 0, 0, scr, r, T.lane); continue; } r -= I_IN;
        if (r < I_G)  {
                        const float* src = args.in[7] + (size_t)l * 262144 + (size_t)r * 2048; const float* sc = args.in[8] + (size_t)l * PW + (r >> 5) * 256 + 4 * T.lane;
                        bf16* dst = (bf16*)(args.ws + WS_TGS + (size_t)l * (MiB / 2)) + (size_t)r * 2048; const f32x4 sv = *(const f32x4*)sc;
#pragma unroll
                        for (int p = 0; p < 8; ++p) { const f32x4 v = *(const f32x4*)(src + p * 256 + 4 * T.lane) * sv; v2u o; o.x = pk2(v.x, v.y); o.y = pk2(v.z, v.w); *(v2u*)(dst + p * 256 + 4 * T.lane) = o; }
                        continue; } r -= I_G;
        if (r < I_PO) { p0_transpose_item(args.in[9] + (size_t)l * PW * D, D, (bf16*)(args.ws + WS_TPO + (size_t)l * 4 * MiB), 1024, 0, 0, scr, r, T.lane); continue; } r -= I_PO;
        if (r < I_SO) { p0_transpose_item(args.in[13] + (size_t)l * SW * D, D, (bf16*)(wl + LW_WPS), 2048, 1024, 0, scr, r, T.lane); continue; } r -= I_SO;
        if (r < I_O)  { p0_transpose_item(args.in[14] + (size_t)l * D * D, D, (bf16*)(wl + LW_WO), D, 0, 0, scr, r, T.lane); continue; } r -= I_O;
        if (r < I_UP) { p0_transpose_item(args.in[17] + (size_t)l * D * NUP, NUP, (bf16*)(wl + LW_UP2), D, 0, 1, scr, r, T.lane); continue; } r -= I_UP;
        p0_transpose_item(args.in[18] + (size_t)l * FF * D, D, (bf16*)(wl + LW_DN2), FF, 0, 0, scr, r, T.lane);
    }
}

__device__ __forceinline__ void norm_phase(Frame& F, const float* xin, float* xout, const bf16* Fb, const float* gpost, float wgt, const float* gnext, bf16* H) {
    const Lane T = opaque_lane();
    const int gw = F.vcu * NWAVES + T.wave, NGW = F.G * NWAVES, lw = 256 * (F.gr & 7) + 64 * (F.gr >> 3) + T.wave;
    for (int i = 0; ; ++i) {
        const int m = F.grp ? (2048 * F.gx + lw + 8 * i) : (gw + NGW * i);
        if (F.grp ? (i >= 8) : (m >= M)) break;
        const f32x4* xr = (const f32x4*)(xin + (size_t)m * D) + T.lane;
        f32x4 x[8];
#pragma unroll
        for (int j = 0; j < 8; ++j) x[j] = xr[64 * j];
        if (Fb) {
            const v2u* fr = (const v2u*)(Fb + (size_t)m * D) + T.lane;
            f32x4 f[8]; float ss = 0.f;
#pragma unroll
            for (int j = 0; j < 8; ++j) { const v2u w = fr[64 * j]; f[j] = (f32x4){bflo(w.x), bfhi(w.x), bflo(w.y), bfhi(w.y)}; ss += (f[j].x * f[j].x + f[j].y * f[j].y) + (f[j].z * f[j].z + f[j].w * f[j].w); }
            const float rs = wgt * __builtin_amdgcn_rsqf(wave_sum(ss) * (1.f / D) + EPS);
            f32x4* xo = (f32x4*)(xout + (size_t)m * D) + T.lane;
#pragma unroll
            for (int j = 0; j < 8; ++j) { const f32x4 g = ((const f32x4*)gpost)[64 * j + T.lane]; x[j] = x[j] + (f[j] * rs) * g; xo[64 * j] = x[j]; }
        }
        if (gnext) {
            float s2 = 0.f;
#pragma unroll
            for (int j = 0; j < 8; ++j) s2 += (x[j].x * x[j].x + x[j].y * x[j].y) + (x[j].z * x[j].z + x[j].w * x[j].w);
            const float rx = __builtin_amdgcn_rsqf(wave_sum(s2) * (1.f / D) + EPS);
            v2u* ho = (v2u*)(H + (size_t)m * D) + T.lane;
#pragma unroll
            for (int j = 0; j < 8; ++j) { const f32x4 g = ((const f32x4*)gnext)[64 * j + T.lane]; const f32x4 v = (x[j] * rx) * g; v2u w; w.x = pg8::cvt_pk_bf16(v.x, v.y); w.y = pg8::cvt_pk_bf16(v.z, v.w); ho[64 * j] = w; }
        }
    }
}

__device__ __forceinline__ void pool_unit(Frame& F, const bf16* P, bf16* DP, int unit) {
    const Lane T = opaque_lane();
    const int cgi = T.tid & 127, tq = T.tid >> 7, c0 = cgi * 8, w = 2 << (cgi >> 5);
    const int ms = unit * 64 + tq * 16, tl0 = ms & (SEQ - 1);
    float S[8];
#pragma unroll
    for (int k = 0; k < 8; ++k) S[k] = 0.f;
    for (int j = 1; j < w; ++j) if (tl0 - j >= 0) { const v4u q = *(const v4u*)(P + (size_t)(ms - j) * PW + c0);
#pragma unroll
        for (int k = 0; k < 4; ++k) { S[2 * k] += bflo(q[k]); S[2 * k + 1] += bfhi(q[k]); } }
    for (int i = 0; i < 16; ++i) {
        const v4u q = *(const v4u*)(P + (size_t)(ms + i) * PW + c0);
        float cur[8];
#pragma unroll
        for (int k = 0; k < 4; ++k) { cur[2 * k] = bflo(q[k]); cur[2 * k + 1] = bfhi(q[k]); }
        const int cnt = (tl0 + i + 1) < w ? (tl0 + i + 1) : w; const float inv = 1.0f / (float)cnt;
        float d[8];
#pragma unroll
        for (int k = 0; k < 8; ++k) { S[k] += cur[k]; d[k] = S[k] * inv - cur[k]; }
        v4u o; o.x = pg8::cvt_pk_bf16(d[0], d[1]); o.y = pg8::cvt_pk_bf16(d[2], d[3]); o.z = pg8::cvt_pk_bf16(d[4], d[5]); o.w = pg8::cvt_pk_bf16(d[6], d[7]);
        *(v4u*)(DP + (size_t)(ms + i) * 2048 + c0) = o;
        if (tl0 + i - w + 1 >= 0) { const v4u r = *(const v4u*)(P + (size_t)(ms + i - w + 1) * PW + c0);
#pragma unroll
            for (int k = 0; k < 4; ++k) { S[2 * k] -= bflo(r[k]); S[2 * k + 1] -= bfhi(r[k]); } }
    }
}

constexpr int SGU_WP = 0, SGU_PITCH = 272, SGU_RSTD = 128 * SGU_PITCH, SGU_RED = SGU_RSTD + 512;
__device__ __forceinline__ void sgu_unit(Frame& F, const bf16* VT, const bf16* U, bf16* YZ, const float* Ws, const float* bs, const float* gain, int unit) {
    const Lane T = opaque_lane();
    const int hg = unit & 1, cn = unit >> 1, m0 = cn * 128;
    LAS unsigned char* L = F.lds + RING_OFF;
    LAS float* rstd = (LAS float*)(L + SGU_RSTD); LAS float* red = (LAS float*)(L + SGU_RED);
    { const int tg = T.tid & 15, cg = T.tid >> 4;
      float ss[8];
#pragma unroll
      for (int k = 0; k < 8; ++k) ss[k] = 0.f;
      const bf16* vt = VT + (size_t)(cg * 32) * M + m0 + 8 * tg;
#pragma unroll 8
      for (int c = 0; c < 32; ++c) { const v4u q = *(const v4u*)(vt + (size_t)c * M);
#pragma unroll
          for (int k = 0; k < 4; ++k) { const float lo = bflo(q[k]), hi = bfhi(q[k]); ss[2 * k] += lo * lo; ss[2 * k + 1] += hi * hi; } }
#pragma unroll
      for (int k = 0; k < 8; ++k) { ss[k] += __shfl_xor(ss[k], 16); ss[k] += __shfl_xor(ss[k], 32); }
      if (T.lane < 16) {
#pragma unroll
          for (int k = 0; k < 8; ++k) red[T.wave * 128 + 8 * tg + k] = ss[k]; }
      __syncthreads();
      if (T.tid < 128) { float s = 0.f;
#pragma unroll
          for (int wv = 0; wv < 8; ++wv) s += red[wv * 128 + T.tid];
          rstd[T.tid] = __builtin_amdgcn_rsqf(s * (1.f / SW) + EPS); }
      __syncthreads();
    }
    const int fr = T.lane & 15, fq = T.lane >> 4;
    for (int hh = 0; hh < 4; ++hh) {
        const int h = hg * 4 + hh;
        { const float* Wh = Ws + (size_t)h * 16384; const int t = T.tid >> 2, sb = (T.tid & 3) * 32;
#pragma unroll
          for (int q = 0; q < 4; ++q) { const int s0 = sb + 8 * q;
              const f32x4 w0 = *(const f32x4*)(Wh + t * 128 + s0), w1 = *(const f32x4*)(Wh + t * 128 + s0 + 4);
              const f32x4 r0 = *(const LAS f32x4*)(rstd + s0), r1 = *(const LAS f32x4*)(rstd + s0 + 4);
              float v[8];
#pragma unroll
              for (int j = 0; j < 4; ++j) { v[j] = (s0 + j <= t) ? w0[j] * r0[j] : 0.f; v[4 + j] = (s0 + 4 + j <= t) ? w1[j] * r1[j] : 0.f; }
              v4u o; o.x = pg8::cvt_pk_bf16(v[0], v[1]); o.y = pg8::cvt_pk_bf16(v[2], v[3]); o.z = pg8::cvt_pk_bf16(v[4], v[5]); o.w = pg8::cvt_pk_bf16(v[6], v[7]);
              *(LAS v4u*)(L + SGU_WP + t * SGU_PITCH + s0 * 2) = o; } }
        __syncthreads();
        const int cbase = h * 128 + 16 * T.wave;
        bf16x8 xf[4];
#pragma unroll
        for (int ks = 0; ks < 4; ++ks) xf[ks] = *(const bf16x8*)(VT + (size_t)(cbase + fr) * M + m0 + ks * 32 + 8 * fq);
        f32x4 acc[8];
#pragma unroll
        for (int jt = 0; jt < 8; ++jt) { acc[jt] = (f32x4){0.f, 0.f, 0.f, 0.f};
#pragma unroll
            for (int ks = 0; ks < 4; ++ks) if (32 * ks <= 16 * jt + 15) { const bf16x8 yf = *(const LAS bf16x8*)(L + SGU_WP + (16 * jt + fr) * SGU_PITCH + (ks * 32 + 8 * fq) * 2);
                acc[jt] = __builtin_amdgcn_mfma_f32_16x16x32_bf16(xf[ks], yf, acc[jt], 0, 0, 0); } }
        const int c4 = cbase + 4 * fq; const f32x4 g4 = *(const f32x4*)(gain + c4);
#pragma unroll
        for (int jt = 0; jt < 8; ++jt) { const int t = 16 * jt + fr; const size_t m = (size_t)(m0 + t);
            const float bias = bs[h * 128 + t]; const v2u uu = *(const v2u*)(U + m * SW + c4);
            const float z0 = bflo(uu.x) * (acc[jt][0] * g4[0] + bias), z1 = bfhi(uu.x) * (acc[jt][1] * g4[1] + bias), z2 = bflo(uu.y) * (acc[jt][2] * g4[2] + bias), z3 = bfhi(uu.y) * (acc[jt][3] * g4[3] + bias);
            v2u o; o.x = pg8::cvt_pk_bf16(z0, z1); o.y = pg8::cvt_pk_bf16(z2, z3);
            *(v2u*)(YZ + m * 2048 + 1024 + c4) = o; }
        __syncthreads();
    }
}

#ifndef PG8_SP2
#define PG8_SP2 true
#endif
#ifndef PG8_ALIGN
#define PG8_ALIGN true
#endif

__global__ void __launch_bounds__(NWAVES * 64, 2) mk_fwd(Args args) {
    extern __shared__ __attribute__((aligned(16))) unsigned char lds[];
    Frame F;
    F.lds = (LAS unsigned char*)lds;
    F.MISC = (volatile LAS unsigned*)(F.lds + MISC_OFF);
    F.G = gridDim.x; { const int bx = blockIdx.x; F.vcu = (F.G % 8 == 0) ? (bx % 8) * (F.G / 8) + bx / 8 : bx; }
    unsigned char* ws = args.ws;
    F.ctl = (gu32*)(ws + WS_CTL);
    for (int u = threadIdx.x; u < (LDS_BYTES - LDSCTL_OFF) / 4; u += NWAVES * 64) ((LAS unsigned*)(F.lds + LDSCTL_OFF))[u] = 0u;
    __syncthreads();
    const int lo = args.ph_lo, hi = args.ph_hi;
    XcdBarrier bar; bar.bar = (unsigned*)(F.ctl + CW_BAR); bar.x = 0; bar.st = nullptr;
    if (hi - lo > 1) bar = xcd_barrier_post((unsigned*)(F.ctl + CW_BAR), F.MISC + 8);
#define IN(k) (lo <= (k) && (k) < hi)
#define SEAM_G(k) do { if (IN(k) && IN((k) + 1)) xcd_barrier(bar, false); } while (0)
#define SEAM_L(k) do { if (IN(k) && IN((k) + 1)) { if (lmode) quad_barrier(qcnt, (unsigned*)(F.ctl + CW_BAR) + XB_TMO); else xcd_barrier(bar, false); } } while (0)
    unsigned* qcnt = (unsigned*)(F.ctl + CW_QUAD);
    F.gx = (int)blockIdx.x & 7; F.gr = (int)blockIdx.x >> 3; F.grp = 0;
    bool lmode = false; int cid = (int)blockIdx.x;

    bf16* const Hb = (bf16*)(ws + WS_H); bf16* const Fb = (bf16*)(ws + WS_F); bf16* const ACT = (bf16*)(ws + WS_ACT);
    bf16* const Ub = (bf16*)(ws + WS_U); bf16* const VT = (bf16*)(ws + WS_VT);
    bf16* const SGA = (bf16*)(ws + WS_SGA); bf16* const SGB = (bf16*)(ws + WS_SGB); bf16* const YZ = (bf16*)(ws + WS_YZ); bf16* const MM = (bf16*)(ws + WS_MM);

    if (IN(0)) { p0_prologue(F, args); norm_phase(F, args.in[0], nullptr, nullptr, nullptr, 0.f, args.in[1], Hb); }
    SEAM_G(0);
    if (hi - lo > 1) {
        const unsigned rk = F.MISC[10], uni = F.MISC[11];
        lmode = (__builtin_amdgcn_readfirstlane(uni) == 1u) && F.G == 256;
        if (lmode) { F.gx = (int)bar.x; F.gr = (int)__builtin_amdgcn_readfirstlane(rk); cid = F.gr * 8 + F.gx; qcnt += 64 * (F.gx * 8 + (F.gr & 7)); }
    }
    F.grp = (F.G == 256);
    if (IN(1)) {
        const int fl = (int)blockIdx.x >> 5;
        if (fl < NL) {
            pg8::Gemm g{(const bf16*)(ws + WS_TPO + (size_t)fl * 4 * MiB), (const bf16*)(ws + WS_TGS + (size_t)fl * (MiB / 2)), D, PW, 256, PW, 256, 256}; pg8::StaticOrder S; S.init(D, PW, 32, (int)blockIdx.x & 31);
            pg8::EpiBf16S E{(bf16*)(ws + WS_W + (size_t)fl * LW_STRIDE + LW_WPS), 2048, nullptr};
            pg8::gemm_phase<pg8::EpiBf16S, pg8::StaticOrder, PG8_ALIGN, PG8_SP2>(F.lds + RING_OFF, g, S, E);
        }
    }
    SEAM_G(1);

    for (int s = 0; s < 2 * NL; ++s) {
        const int l = s >> 1, second = s & 1, pb = 2 + 11 * l + (second ? 8 : 0);
        unsigned char* wl = ws + WS_W + (size_t)l * LW_STRIDE;
        if (IN(pb)) {
            pg8::Gemm g{Hb, (const bf16*)(wl + (second ? LW_UP2 : LW_UP1)), M, NUP, D, D, D, 0}; pg8::StaticOrder S; S.init(M, NUP, F.G, cid);
            pg8::EpiSwiGLU E{ACT, FF};
            pg8::gemm_phase<pg8::EpiSwiGLU, pg8::StaticOrder, PG8_ALIGN, PG8_SP2>(F.lds + RING_OFF, g, S, E);
        }
        SEAM_L(pb);
        if (IN(pb + 1)) {
            pg8::Gemm g{ACT, (const bf16*)(wl + (second ? LW_DN2 : LW_DN1)), M, D, FF, FF, FF, 0}; pg8::StaticOrder S; S.init(M, D, F.G, cid);
            pg8::EpiBf16S E{Fb, D, nullptr};
            pg8::gemm_phase<pg8::EpiBf16S, pg8::StaticOrder, PG8_ALIGN, PG8_SP2>(F.lds + RING_OFF, g, S, E);
        }
        SEAM_L(pb + 1);
        if (IN(pb + 2)) {
            const float* xin = (s == 0) ? args.in[0] : args.out;
            const float* gpost = (second ? args.in[19] : args.in[4]) + (size_t)l * D;
            const float* gnext = second ? (l + 1 < NL ? args.in[1] + (size_t)(l + 1) * D : nullptr) : args.in[5] + (size_t)l * D;
            norm_phase(F, xin, args.out, Fb, gpost, 0.5f, gnext, Hb);
        }
        SEAM_L(pb + 2);
        if (!second) {
            if (IN(pb + 3)) {
                pg8::Gemm g{Hb, (const bf16*)(wl + LW_WIN), M, NIN, D, D, D, 0}; pg8::StaticOrder S; S.init(M, NIN, F.G, cid);
                pg8::EpiInProj E{(bf16*)(ws + ((l & 1) ? WS_P1 : WS_P)), Ub, VT, SGA, SGB, M};
                pg8::gemm_phase<pg8::EpiInProj, pg8::StaticOrder, PG8_ALIGN, PG8_SP2>(F.lds + RING_OFF, g, S, E);
            }
            SEAM_G(pb + 3);
            if (IN(pb + 4)) {
                const int u0 = F.grp ? 32 * F.gx + 4 * (F.gr & 7) + (F.gr >> 3) : F.vcu;
                for (int u = u0; u < M / 64; u += F.G) pool_unit(F, (const bf16*)(ws + ((l & 1) ? WS_P1 : WS_P)), YZ, u);
                for (int u = u0; u < 2 * (M / 128); u += F.G)
                    sgu_unit(F, VT, Ub, YZ, args.in[11] + (size_t)l * 8 * 16384, args.in[12] + (size_t)l * 8 * 128, args.in[10] + (size_t)l * SW, u);
            }
            SEAM_L(pb + 4);
            if (IN(pb + 5)) {
                pg8::Gemm g{YZ, (const bf16*)(wl + LW_WPS), M, D, 2048, 2048, 2048, 0}; pg8::StaticOrder S; S.init(M, D, F.G, cid);
                pg8::EpiGate E{SGA, SGB, MM};
                pg8::gemm_phase<pg8::EpiGate, pg8::StaticOrder, PG8_ALIGN, PG8_SP2>(F.lds + RING_OFF, g, S, E);
            }
            SEAM_L(pb + 5);
            if (IN(pb + 6)) {
                pg8::Gemm g{MM, (const bf16*)(wl + LW_WO), M, D, D, D, D, 0}; pg8::StaticOrder S; S.init(M, D, F.G, cid);
                pg8::EpiBf16S E{Fb, D, nullptr};
                pg8::gemm_phase<pg8::EpiBf16S, pg8::StaticOrder, PG8_ALIGN, PG8_SP2>(F.lds + RING_OFF, g, S, E);
            }
            SEAM_L(pb + 6);
            if (IN(pb + 7)) norm_phase(F, args.out, args.out, Fb, args.in[15] + (size_t)l * D, 1.0f, args.in[16] + (size_t)l * D, Hb);
            SEAM_L(pb + 7);
        }
    }
#undef IN
#undef SEAM_G
#undef SEAM_L
}

extern "C" void kernel_launch(void* const* d_in, const int* in_sizes, int n_in, void* d_out, int out_size, void* d_ws, size_t ws_size, hipStream_t stream) {
    static int grid = 0;
    if (grid == 0) {
        if (n_in != 20 || in_sizes[0] != M * D || out_size != M * D || ws_size < WS_END) { fprintf(stderr, "kernel_launch: shape/workspace mismatch: n_in %d in0 %d out %d ws %zu (need %zu)\n", n_in, n_in > 0 ? in_sizes[0] : -1, out_size, ws_size, (size_t)WS_END); grid = -1; return; }
        int dev = 0, cus = 0, per_cu = 0;
        if (hipGetDevice(&dev) != hipSuccess || hipDeviceGetAttribute(&cus, hipDeviceAttributeMultiprocessorCount, dev) != hipSuccess) { fprintf(stderr, "kernel_launch: device query failed\n"); grid = -1; return; }
        if (hipFuncSetAttribute((const void*)mk_fwd, hipFuncAttributeMaxDynamicSharedMemorySize, LDS_BYTES) != hipSuccess) { fprintf(stderr, "kernel_launch: hipFuncSetAttribute failed\n"); grid = -1; return; }
        if (hipOccupancyMaxActiveBlocksPerMultiprocessor(&per_cu, (const void*)mk_fwd, NWAVES * 64, LDS_BYTES) != hipSuccess || per_cu < 1) { fprintf(stderr, "kernel_launch: occupancy query reports %d workgroups per CU\n", per_cu); per_cu = 1; }
        (void)hipGetLastError();
        grid = cus;
    }
    if (grid < 0) return;
    if (hipMemsetAsync((char*)d_ws + WS_CTL, 0, CTL_ZERO_BYTES, stream) != hipSuccess) { fprintf(stderr, "kernel_launch: memset failed\n"); return; }
    Args a{};
    for (int i = 0; i < 20; ++i) a.in[i] = (const float*)d_in[i];
    a.out = (float*)d_out; a.ws = (unsigned char*)d_ws;
#if MK_ONE_LAUNCH
    a.ph_lo = 0; a.ph_hi = N_PHASES;
    hipLaunchKernelGGL(mk_fwd, dim3(grid), dim3(NWAVES * 64), LDS_BYTES, stream, a);
#else
    for (int p = 0; p < N_PHASES; ++p) { a.ph_lo = p; a.ph_hi = p + 1; hipLaunchKernelGGL(mk_fwd, dim3(grid), dim3(NWAVES * 64), LDS_BYTES, stream, a); }
#endif
    const hipError_t le = hipPeekAtLastError();
    if (le != hipSuccess) fprintf(stderr, "kernel_launch: launch failed: %s\n", hipGetErrorName(le));
}
```

```cpp
#include <hip/hip_runtime.h>
#include <cstdio>
#include <cstdint>

#ifndef STAGGER_US
#define STAGGER_US 0
#endif
#ifndef MK_FORCE_GRID_BARRIERS
#define MK_FORCE_GRID_BARRIERS 0
#endif
#ifndef W_AUX
#define W_AUX 19
#endif
#ifndef MK_ONE_LAUNCH
#define MK_ONE_LAUNCH 1
#endif

namespace pg8 {
#define PG8_LAS __attribute__((address_space(3)))
typedef unsigned short bf16_t;
typedef short bf16x8 __attribute__((ext_vector_type(8)));
typedef float f32x4 __attribute__((ext_vector_type(4)));
typedef float f32x2 __attribute__((ext_vector_type(2)));
typedef unsigned u32x4 __attribute__((ext_vector_type(4)));
typedef unsigned u32x2 __attribute__((ext_vector_type(2)));
constexpr int BM = 256, BK = 64, HALF = 128, HTB = HALF * BK * 2  , STAGE_BYTES = 8 * HTB, NXCD = 8, WGM = 8;

__host__ __device__ __forceinline__ int lds_byte(int r, int c) { const int st = (r >> 4) * 2 + (c >> 5), rr = r & 15, cc = c & 31, ob = rr * 64 + cc * 2; return st * 1024 + (ob ^ (((ob >> 9) & 1) << 5)); }
__host__ __device__ __forceinline__ void stage_rc(int b, int& R, int& C) { const int st = b / 1024, sb = b % 1024, swz = sb ^ (((sb >> 9) & 1) << 5); R = (st >> 1) * 16 + swz / 64; C = (st & 1) * 32 + (swz % 64) / 2; }
__host__ __device__ __forceinline__ int perm32(int rho) { const int n = rho >> 4, i = rho & 15; return 8 * (i >> 2) + 4 * n + (i & 3); }

__host__ __device__ __forceinline__ size_t blk_byte(int r, int c, int K) { return ((size_t)(r >> 7) * (size_t)(K >> 6) + (size_t)(c >> 6)) * 16384 + (size_t)lds_byte(r & 127, c & 63); }
struct Unit { int pm, pn; };
struct Gemm { const bf16_t* A; const bf16_t* Bt; int M, N, K, lda, ldb, a_pn_koff; const char* base = nullptr; };

struct StaticOrder {
    int nM, nN, nwg, G, c;
    __host__ __device__ void init(int M, int N, int G_, int c_) { nM = M / BM; nN = N / BM; nwg = nM * nN; G = G_; c = c_; }
    __host__ __device__ bool next(int i, Unit& u) const {
        const long L = (long)i * G + c; if (L >= nwg) return false;
        int wgid = (int)L; { const int q = nwg / NXCD, r = nwg % NXCD, xcd = wgid % NXCD, off = wgid / NXCD; wgid = (xcd < r ? xcd * (q + 1) : r * (q + 1) + (xcd - r) * q) + off; }
        const int nig = WGM * nN, gid = wgid / nig, fm = gid * WGM, gsz = (nM - fm) < WGM ? (nM - fm) : WGM;
        u.pm = fm + ((wgid % nig) % gsz); u.pn = (wgid % nig) / gsz; return true;
    }
    __device__ __forceinline__ void a_ready(const Unit&) const {}
    __device__ __forceinline__ void done(const Unit&) const {}
};

__device__ __forceinline__ unsigned cvt_pk_bf16(float lo, float hi) { unsigned r; asm volatile("v_cvt_pk_bf16_f32 %0, %1, %2" : "=v"(r) : "v"(lo), "v"(hi)); return r; }
__device__ __forceinline__ float bf_lo(unsigned w) { return __uint_as_float(w << 16); }
__device__ __forceinline__ float bf_hi(unsigned w) { return __uint_as_float(w & 0xffff0000u); }
__device__ __forceinline__ float sigmoid_f(float x) { return __builtin_amdgcn_rcpf(1.0f + __builtin_amdgcn_exp2f(-1.4426950408889634f * x)); }
__device__ __forceinline__ float silu_f(float x) { return x * sigmoid_f(x); }
__device__ __forceinline__ float gelu_f(float x) { const float y = 1.5957691216057308f * (x + 0.044715f * x * x * x); return x * sigmoid_f(y); }
__device__ __forceinline__ f32x4 exp2_4(const f32x4 z) { return (f32x4){__builtin_amdgcn_exp2f(z[0]), __builtin_amdgcn_exp2f(z[1]), __builtin_amdgcn_exp2f(z[2]), __builtin_amdgcn_exp2f(z[3])}; }
__device__ __forceinline__ f32x4 rcp_4(const f32x4 d) { return (f32x4){__builtin_amdgcn_rcpf(d[0]), __builtin_amdgcn_rcpf(d[1]), __builtin_amdgcn_rcpf(d[2]), __builtin_amdgcn_rcpf(d[3])}; }
__device__ __forceinline__ f32x4 sigmoid_4(const f32x4 x) { return rcp_4(exp2_4(x * -1.4426950408889634f) + 1.0f); }
__device__ __forceinline__ f32x4 gelu_4(const f32x4 x) { const float c1 = -1.4426950408889634f * 1.5957691216057308f, c2 = c1 * 0.044715f; const f32x4 z = x * ((x * x) * c2 + c1); return x * rcp_4(exp2_4(z) + 1.0f); }
__device__ __forceinline__ f32x4 swiglu_4(const f32x4 g, const f32x4 u) { return (g * u) * sigmoid_4(g); }
__device__ __forceinline__ u32x4 pack8(const f32x4 v0, const f32x4 v1) { u32x4 w; w.x = cvt_pk_bf16(v0[0], v0[1]); w.y = cvt_pk_bf16(v0[2], v0[3]); w.z = cvt_pk_bf16(v1[0], v1[1]); w.w = cvt_pk_bf16(v1[2], v1[3]); return w; }

struct EpiSwiGLU {
    static constexpr bool PERM = true, AFTER_DRAIN = false, SWAP = false, MID = false;
    bf16_t* O; int ldc;
    __device__ __forceinline__ bool swapped(const Unit&) const { return false; }
    __device__ __forceinline__ void mid(f32x4 (&)[2][2][4][2], const Unit&, int, int, int, int) const {}
    __device__ __forceinline__ void operator()(const f32x4 (&acc)[2][2][4][2], const Unit& u, int wr, int wc, int fr, int fq) const {
        const int row0 = u.pm * BM + wr * 64 + fr, col0 = u.pn * HALF + wc * 32 + 8 * fq;
#pragma unroll
        for (int ai = 0; ai < 2; ++ai)
#pragma unroll
            for (int m = 0; m < 4; ++m) { bf16_t* rowp = (bf16_t*)((char*)O + blk_byte(row0 + ai * HALF + m * 16, col0, ldc));
                const f32x4 v0 = swiglu_4(acc[ai][0][m][0], acc[ai][1][m][0]), v1 = swiglu_4(acc[ai][0][m][1], acc[ai][1][m][1]);
                *(u32x4*)rowp = pack8(v0, v1); }
    }
};
struct EpiBf16S {
    static constexpr bool PERM = true, AFTER_DRAIN = false, SWAP = false, MID = false;
    bf16_t* O; int ldc; const float* scale; int tiled;
    __device__ __forceinline__ bool swapped(const Unit&) const { return false; }
    __device__ __forceinline__ void mid(f32x4 (&)[2][2][4][2], const Unit&, int, int, int, int) const {}
    __device__ __forceinline__ void operator()(const f32x4 (&acc)[2][2][4][2], const Unit& u, int wr, int wc, int fr, int fq) const {
        const int row0 = u.pm * BM + wr * 64 + fr, col0 = u.pn * BM + wc * 32 + 8 * fq;
        f32x4 sv[2][2];
#pragma unroll
        for (int bj = 0; bj < 2; ++bj)
#pragma unroll
            for (int n = 0; n < 2; ++n) sv[bj][n] = scale ? *(const f32x4*)(scale + col0 + bj * HALF + 4 * n) : (f32x4){1.f, 1.f, 1.f, 1.f};
#pragma unroll
        for (int ai = 0; ai < 2; ++ai)
#pragma unroll
            for (int m = 0; m < 4; ++m) { const int r = row0 + ai * HALF + m * 16;
#pragma unroll
                for (int bj = 0; bj < 2; ++bj) { bf16_t* p = tiled ? (bf16_t*)((char*)O + blk_byte(r, col0 + bj * HALF, ldc)) : O + (size_t)r * ldc + col0 + bj * HALF;
                    *(u32x4*)p = pack8(acc[ai][bj][m][0] * sv[bj][0], acc[ai][bj][m][1] * sv[bj][1]); } }
    }
};
struct EpiInProj {
    static constexpr bool PERM = true, AFTER_DRAIN = false, SWAP = true, MID = false;
    bf16_t *P, *U, *VT, *SGA, *SGB; int Mrows; float* SSQ;
    __device__ __forceinline__ bool swapped(const Unit& u) const { return u.pn >= 8 && u.pn < 12; }
    __device__ __forceinline__ void mid(f32x4 (&)[2][2][4][2], const Unit&, int, int, int, int) const {}
    __device__ __forceinline__ void operator()(const f32x4 (&acc)[2][2][4][2], const Unit& u, int wr, int wc, int fr, int fq) const {
        bf16_t* base; int ldc, rbase, cbase, act;
        if (u.pn < 4)       { base = P;   ldc = 1024;  rbase = u.pm * BM;       cbase = u.pn * BM;        act = 0; }
        else if (u.pn < 8)  { base = U;   ldc = 1024;  rbase = u.pm * BM;       cbase = (u.pn - 4) * BM;  act = 1; }
        else if (u.pn < 12) { base = VT;  ldc = Mrows; rbase = (u.pn - 8) * BM; cbase = u.pm * BM;        act = 1; }
        else if (u.pn < 20) { base = SGA; ldc = 2048;  rbase = u.pm * BM;       cbase = (u.pn - 12) * BM; act = 2; }
        else                { base = SGB; ldc = 2048;  rbase = u.pm * BM;       cbase = (u.pn - 20) * BM; act = 2; }
        const int row0 = rbase + wr * 64 + fr, col0 = cbase + wc * 32 + 8 * fq;
        const bool vt = u.pn >= 8 && u.pn < 12;
        f32x4 sq[2][2];
#pragma unroll
        for (int bj = 0; bj < 2; ++bj)
#pragma unroll
            for (int n = 0; n < 2; ++n) sq[bj][n] = (f32x4){0.f, 0.f, 0.f, 0.f};
#pragma unroll
        for (int ai = 0; ai < 2; ++ai)
#pragma unroll
            for (int m = 0; m < 4; ++m) { bf16_t* rowp = base + (size_t)(row0 + ai * HALF + m * 16) * ldc + col0;
#pragma unroll
                for (int bj = 0; bj < 2; ++bj) { f32x4 v0 = acc[ai][bj][m][0], v1 = acc[ai][bj][m][1];
                    if (act == 1) { v0 = gelu_4(v0); v1 = gelu_4(v1);
                        if (vt) { sq[bj][0] += v0 * v0; sq[bj][1] += v1 * v1; } }
                    else if (act == 2) { v0 = sigmoid_4(v0); v1 = sigmoid_4(v1); }
                    *(u32x4*)(rowp + bj * HALF) = pack8(v0, v1); } }
        if (vt) {
#pragma unroll
            for (int bj = 0; bj < 2; ++bj)
#pragma unroll
                for (int n = 0; n < 2; ++n)
#pragma unroll
                    for (int j = 0; j < 4; ++j) { float t = sq[bj][n][j]; t += __shfl_xor(t, 1); t += __shfl_xor(t, 2); t += __shfl_xor(t, 4); t += __shfl_xor(t, 8); sq[bj][n][j] = t; }
            if (fr == 0) { float* dst = SSQ + (size_t)((u.pn - 8) * 2 + wr) * Mrows + cbase + wc * 32 + 8 * fq;
#pragma unroll
                for (int bj = 0; bj < 2; ++bj)
#pragma unroll
                    for (int n = 0; n < 2; ++n) *(f32x4*)(dst + bj * HALF + 4 * n) = sq[bj][n]; }
        }
    }
};
struct EpiGate {
    static constexpr bool PERM = true, AFTER_DRAIN = false, SWAP = false, MID = true;
    const bf16_t *SGA, *SGB; bf16_t* O;
    __device__ __forceinline__ bool swapped(const Unit&) const { return false; }
    __device__ __forceinline__ void mid(f32x4 (&acc)[2][2][4][2], const Unit& u, int wr, int wc, int fr, int fq) const {
        const int row0 = u.pm * BM + wr * 64 + fr, col0 = u.pn * BM + wc * 32 + 8 * fq;
#pragma unroll
        for (int ai = 0; ai < 2; ++ai)
#pragma unroll
            for (int m = 0; m < 4; ++m) { const size_t off = (size_t)(row0 + ai * HALF + m * 16) * 2048 + col0;
#pragma unroll
                for (int bj = 0; bj < 2; ++bj) { const u32x4 a = *(const u32x4*)(SGA + off + bj * HALF), b = *(const u32x4*)(SGB + off + bj * HALF);
#pragma unroll
                    for (int k = 0; k < 4; ++k) { const float rl = bf_lo(a[k]) * __builtin_amdgcn_rcpf(fmaxf(bf_lo(b[k]), 1e-30f)), rh = bf_hi(a[k]) * __builtin_amdgcn_rcpf(fmaxf(bf_hi(b[k]), 1e-30f));
                        acc[ai][bj][m][k >> 1][(k & 1) * 2] *= rl; acc[ai][bj][m][k >> 1][(k & 1) * 2 + 1] *= rh; } } }
    }
    __device__ __forceinline__ void operator()(const f32x4 (&acc)[2][2][4][2], const Unit& u, int wr, int wc, int fr, int fq) const {
        const int row0 = u.pm * BM + wr * 64 + fr, col0 = u.pn * BM + wc * 32 + 8 * fq;
#pragma unroll
        for (int ai = 0; ai < 2; ++ai)
#pragma unroll
            for (int m = 0; m < 4; ++m) { const size_t off = (size_t)(row0 + ai * HALF + m * 16) * 2048 + col0;
#pragma unroll
                for (int bj = 0; bj < 2; ++bj) { const u32x4 b = *(const u32x4*)(SGB + off + bj * HALF);
                    const f32x4 s0 = {fmaxf(bf_lo(b[0]), 1e-30f), fmaxf(bf_hi(b[0]), 1e-30f), fmaxf(bf_lo(b[1]), 1e-30f), fmaxf(bf_hi(b[1]), 1e-30f)};
                    const f32x4 s1 = {fmaxf(bf_lo(b[2]), 1e-30f), fmaxf(bf_hi(b[2]), 1e-30f), fmaxf(bf_lo(b[3]), 1e-30f), fmaxf(bf_hi(b[3]), 1e-30f)};
                    *(u32x4*)((char*)O + blk_byte(row0 + ai * HALF + m * 16, col0 + bj * HALF, 2048)) = pack8(acc[ai][bj][m][0] * s0, acc[ai][bj][m][1] * s1); } }
    }
};

template <class Epi, class Sched, bool ALIGN_EPI = false, bool SP2 = false>
__device__ __forceinline__ void gemm_phase(PG8_LAS unsigned char* lds, const Gemm g, const Sched& S, const Epi& E) {
    int tid = threadIdx.x; asm volatile("" : "+v"(tid));
    const int wid = __builtin_amdgcn_readfirstlane(tid >> 6), lane = tid & 63, wr = wid >> 2, wc = wid & 3, fr = lane & 15, fq = lane >> 4;
    const int K = g.K, nt = K / BK;
    const __amdgpu_buffer_rsrc_t rs = __builtin_amdgcn_make_buffer_rsrc((void*)g.base, 0, 0xffffffff, 0x00020000);
    unsigned voffA[2], voffB[2];
#pragma unroll
    for (int i = 0; i < 2; ++i) { voffA[i] = (unsigned)(wid * 2048 + lane * 16 + i * 1024); voffB[i] = voffA[i]; }
    const size_t kstep = (size_t)HTB;
    const size_t hstepA = (size_t)g.lda * 256, hstepB = (size_t)g.ldb * 256;
    const size_t tstepA = 2 * hstepA, tstepB = 2 * hstepB;
    const unsigned ldsw = (unsigned)wid * 2048u;
    const int aoff = lds_byte(wr * 64 + fr, fq * 8);
    const int boff0 = lds_byte(wc * 32 + (Epi::PERM ? perm32(fr) : fr), fq * 8), boff1 = lds_byte(wc * 32 + (Epi::PERM ? perm32(16 + fr) : 16 + fr), fq * 8);
#define PG8_SA(b, h) (((b) * 2 + (h)) * HTB)
#define PG8_SB(b, h) ((4 + (b) * 2 + (h)) * HTB)
#define PG8_STAGE(bufoff, gbase, voff) do { const int _so = (int)(unsigned)((size_t)(gbase) - (size_t)g.base); PG8_LAS void* _l = (PG8_LAS void*)(lds + (bufoff) + ldsw); \
        __builtin_amdgcn_raw_ptr_buffer_load_lds(rs, _l, 16, (int)(voff)[0], _so, 0, 0); __builtin_amdgcn_raw_ptr_buffer_load_lds(rs, _l, 16, (int)(voff)[0], _so, 1024, 0); } while (0)
#define PG8_LDA(dst, b, h) do { _Pragma("unroll") for (int m = 0; m < 4; ++m) _Pragma("unroll") for (int k = 0; k < 2; ++k) dst[m][k] = *(const PG8_LAS bf16x8*)(lds + PG8_SA(b, h) + aoff + m * 2048 + k * 1024); } while (0)
#define PG8_LDB(dst, b, h) do { _Pragma("unroll") for (int n = 0; n < 2; ++n) _Pragma("unroll") for (int k = 0; k < 2; ++k) dst[n][k] = *(const PG8_LAS bf16x8*)(lds + PG8_SB(b, h) + (n ? boff1 : boff0) + k * 1024); } while (0)
#define PG8_MMA(ai, bj, At, Bt) do { __builtin_amdgcn_s_setprio(1); _Pragma("unroll") for (int m = 0; m < 4; ++m) _Pragma("unroll") for (int n = 0; n < 2; ++n) _Pragma("unroll") for (int k = 0; k < 2; ++k) \
        acc[ai][bj][m][n] = __builtin_amdgcn_mfma_f32_16x16x32_bf16(Bt[n][k], At[m][k], acc[ai][bj][m][n], 0, 0, 0); __builtin_amdgcn_s_setprio(0); } while (0)
#define PG8_WAIT_V(n) asm volatile("s_waitcnt vmcnt(" #n ")" ::: "memory")
#define PG8_WAIT_L(n) asm volatile("s_waitcnt lgkmcnt(" #n ")" ::: "memory")
#define PG8_BAR __builtin_amdgcn_s_barrier()
#define PG8_SCHED __builtin_amdgcn_sched_barrier(0)
#define PG8_UNIT_PTRS(u, pa, pb) do { const char* _a = (const char*)g.A + (size_t)(u).pm * tstepA + (size_t)(u).pn * (size_t)(g.a_pn_koff >> 6) * HTB; const char* _b = (const char*)g.Bt + (size_t)(u).pn * tstepB; \
        if (Epi::SWAP && E.swapped(u)) { pa = _b; pb = _a; } else { pa = _a; pb = _b; } } while (0)
    Unit cur, nxt; int ui = 0;
    if (!S.next(0, cur)) return;
    f32x4 acc[2][2][4][2];
#pragma unroll
    for (int a = 0; a < 2; ++a)
#pragma unroll
        for (int b = 0; b < 2; ++b)
#pragma unroll
            for (int m = 0; m < 4; ++m)
#pragma unroll
                for (int n = 0; n < 2; ++n) acc[a][b][m][n] = (f32x4){0.f, 0.f, 0.f, 0.f};
    bf16x8 At[4][2], B0[2][2], B1[2][2];
    const char* cA; const char* cB; PG8_UNIT_PTRS(cur, cA, cB);
    S.a_ready(cur);
    if constexpr (SP2) {
        PG8_STAGE(PG8_SB(0, 0), cB, voffB); PG8_STAGE(PG8_SB(0, 1), cB + hstepB, voffB); PG8_STAGE(PG8_SA(0, 0), cA, voffA); PG8_STAGE(PG8_SA(0, 1), cA + hstepA, voffA);
        if (wr == 1) PG8_BAR;
        PG8_WAIT_V(2); PG8_BAR;
        PG8_STAGE(PG8_SB(1, 0), cB + kstep, voffB); PG8_STAGE(PG8_SA(1, 0), cA + kstep, voffA); PG8_STAGE(PG8_SB(1, 1), cB + hstepB + kstep, voffB);
        PG8_WAIT_V(6); PG8_BAR;
    } else {
        PG8_STAGE(PG8_SB(0, 0), cB, voffB); PG8_STAGE(PG8_SA(0, 0), cA, voffA); PG8_STAGE(PG8_SB(0, 1), cB + hstepB, voffB); PG8_STAGE(PG8_SA(0, 1), cA + hstepA, voffA);
        if (wr == 1) PG8_BAR;
        PG8_WAIT_V(4); PG8_BAR;
        PG8_STAGE(PG8_SB(1, 0), cB + kstep, voffB); PG8_STAGE(PG8_SA(1, 0), cA + kstep, voffA); PG8_STAGE(PG8_SB(1, 1), cB + hstepB + kstep, voffB);
        PG8_WAIT_V(6); PG8_BAR;
    }
    for (;;) {
        const bool has_next = S.next(ui + 1, nxt);
        const char* nA = cA; const char* nB = cB; if (has_next) PG8_UNIT_PTRS(nxt, nA, nB);
        for (int t = 0; t < nt; t += 2) {
            const bool last = (t == nt - 2);
            const char* a1 = cA + (size_t)(t + 1) * kstep;
            const char* a2 = last ? nA : cA + (size_t)(t + 2) * kstep; const char* b2 = last ? nB : cB + (size_t)(t + 2) * kstep;
            const char* a3 = a2 + kstep; const char* b3 = b2 + kstep;
            if (last && has_next) S.a_ready(nxt);
            if constexpr (Epi::MID) { if (t == (nt >> 1)) { int tz = threadIdx.x; asm volatile("" : "+v"(tz)); const int w2 = __builtin_amdgcn_readfirstlane(tz >> 6), l2 = tz & 63; E.mid(acc, cur, w2 >> 2, w2 & 3, l2 & 15, l2 >> 4); } }
            if constexpr (SP2) {
            PG8_LDB(B0, 0, 0); PG8_LDB(B1, 0, 1); PG8_SCHED; PG8_LDA(At, 0, 0); PG8_STAGE(PG8_SA(1, 1), a1 + hstepA, voffA);
            PG8_WAIT_V(8); PG8_WAIT_L(0); PG8_BAR; PG8_MMA(0, 0, At, B0); PG8_MMA(0, 1, At, B1); PG8_BAR; PG8_SCHED;
            PG8_LDA(At, 0, 1); PG8_STAGE(PG8_SB(0, 0), b2, voffB); PG8_STAGE(PG8_SB(0, 1), b2 + hstepB, voffB); PG8_STAGE(PG8_SA(0, 0), a2, voffA);
            PG8_WAIT_V(8); PG8_WAIT_L(0); PG8_BAR; PG8_MMA(1, 0, At, B0); PG8_MMA(1, 1, At, B1); PG8_BAR; PG8_SCHED;
            PG8_LDB(B0, 1, 0); PG8_LDB(B1, 1, 1); PG8_SCHED; PG8_LDA(At, 1, 0); PG8_STAGE(PG8_SA(0, 1), a2 + hstepA, voffA);
            PG8_WAIT_V(8); PG8_WAIT_L(0); PG8_BAR; PG8_MMA(0, 0, At, B0); PG8_MMA(0, 1, At, B1); PG8_BAR; PG8_SCHED;
            PG8_LDA(At, 1, 1); PG8_STAGE(PG8_SB(1, 0), b3, voffB); PG8_STAGE(PG8_SB(1, 1), b3 + hstepB, voffB); PG8_STAGE(PG8_SA(1, 0), a3, voffA);
            PG8_WAIT_V(8); PG8_WAIT_L(0); PG8_BAR; PG8_MMA(1, 0, At, B0); PG8_MMA(1, 1, At, B1); PG8_BAR; PG8_SCHED;
            } else {
            PG8_LDB(B0, 0, 0); PG8_SCHED; PG8_LDA(At, 0, 0); PG8_STAGE(PG8_SA(1, 1), a1 + hstepA, voffA);
            PG8_WAIT_L(8); PG8_BAR; PG8_WAIT_L(0); PG8_MMA(0, 0, At, B0); PG8_BAR; PG8_SCHED;
            PG8_LDB(B1, 0, 1); PG8_STAGE(PG8_SB(0, 0), b2, voffB);
            PG8_BAR; PG8_WAIT_L(0); PG8_MMA(0, 1, At, B1); PG8_BAR;
            PG8_LDA(At, 0, 1); PG8_STAGE(PG8_SA(0, 0), a2, voffA);
            PG8_BAR; PG8_WAIT_L(0); PG8_MMA(1, 0, At, B0); PG8_BAR; PG8_SCHED;
            PG8_STAGE(PG8_SB(0, 1), b2 + hstepB, voffB);
            PG8_WAIT_V(6); PG8_BAR; PG8_MMA(1, 1, At, B1); PG8_BAR;
            PG8_LDB(B0, 1, 0); PG8_SCHED; PG8_LDA(At, 1, 0); PG8_STAGE(PG8_SA(0, 1), a2 + hstepA, voffA);
            PG8_WAIT_L(8); PG8_BAR; PG8_WAIT_L(0); PG8_MMA(0, 0, At, B0); PG8_BAR; PG8_SCHED;
            PG8_LDB(B1, 1, 1); PG8_STAGE(PG8_SB(1, 0), b3, voffB);
            PG8_BAR; PG8_WAIT_L(0); PG8_MMA(0, 1, At, B1); PG8_BAR;
            PG8_LDA(At, 1, 1); PG8_STAGE(PG8_SA(1, 0), a3, voffA);
            PG8_BAR; PG8_WAIT_L(0); PG8_MMA(1, 0, At, B0); PG8_BAR; PG8_SCHED;
            PG8_STAGE(PG8_SB(1, 1), b3 + hstepB, voffB);
            PG8_WAIT_V(6); PG8_BAR; PG8_MMA(1, 1, At, B1); PG8_BAR;
            }
        }
        if constexpr (ALIGN_EPI) { if (wr == 0) PG8_BAR; }
        { int tz = threadIdx.x; asm volatile("" : "+v"(tz)); const int w2 = __builtin_amdgcn_readfirstlane(tz >> 6), l2 = tz & 63; E(acc, cur, w2 >> 2, w2 & 3, l2 & 15, l2 >> 4); }
        S.done(cur);
        if (!has_next) break;
#pragma unroll
        for (int a = 0; a < 2; ++a)
#pragma unroll
            for (int b = 0; b < 2; ++b)
#pragma unroll
                for (int m = 0; m < 4; ++m)
#pragma unroll
                    for (int n = 0; n < 2; ++n) acc[a][b][m][n] = (f32x4){0.f, 0.f, 0.f, 0.f};
        cur = nxt; cA = nA; cB = nB; ++ui;
        if constexpr (ALIGN_EPI) { if (wr == 1) PG8_BAR; }
    }
    PG8_WAIT_V(0);
    if constexpr (!ALIGN_EPI) { if (wr == 0) PG8_BAR; }
    PG8_BAR;
#undef PG8_SA
#undef PG8_SB
#undef PG8_STAGE
#undef PG8_LDA
#undef PG8_LDB
#undef PG8_MMA
#undef PG8_WAIT_V
#undef PG8_WAIT_L
#undef PG8_BAR
#undef PG8_SCHED
#undef PG8_UNIT_PTRS
}
}

constexpr int NWAVES = 8;
constexpr int BATCH = 4, SEQ = 4096, D = 2048, FF = 5632, NUP = 2 * FF, NIN = 7168, PW = 1024, SW = 1024, NL = 4;
constexpr int M = BATCH * SEQ;
constexpr float EPS = 1e-6f;
constexpr int N_PHASES = 2 + 11 * NL;

constexpr size_t MiB = 1u << 20;
constexpr size_t WS_CTL = 0, CTL_ZERO_BYTES = 1 * MiB;
constexpr size_t WS_W = 2 * MiB;
constexpr size_t LW_UP1 = 0, LW_DN1 = 44 * MiB, LW_WIN = 66 * MiB, LW_WG = 94 * MiB, LW_WPS = 94 * MiB + MiB / 2, LW_WO = 102 * MiB + MiB / 2, LW_UP2 = 110 * MiB + MiB / 2, LW_DN2 = 154 * MiB + MiB / 2;
constexpr size_t LW_STRIDE = 176 * MiB + MiB / 2;
static_assert((size_t)NUP * D * 2 == 44 * MiB && (size_t)D * FF * 2 == 22 * MiB && (size_t)NIN * D * 2 == 28 * MiB && (size_t)1024 * 256 * 2 == MiB / 2 && (size_t)D * D * 2 == 8 * MiB, "weight sizes");
constexpr size_t WS_H = WS_W + NL * LW_STRIDE;
constexpr size_t WS_F = WS_H + 64 * MiB;
constexpr size_t WS_R = WS_F + 64 * MiB;
constexpr size_t WS_P = WS_R, WS_U = WS_R + 32 * MiB, WS_VT = WS_R + 64 * MiB, WS_P1 = WS_R + 96 * MiB, WS_SGA = WS_R + 128 * MiB, WS_SGB = WS_R + 192 * MiB, WS_YZ = WS_R + 256 * MiB, WS_MM = WS_R + 320 * MiB;
constexpr size_t WS_ACT = WS_R + 384 * MiB;
constexpr size_t WS_SSQ = WS_ACT + 176 * MiB;
constexpr size_t WS_XB = WS_SSQ + 1 * MiB;
constexpr size_t WS_END = WS_XB + 64 * MiB;
constexpr size_t WS_TPO = WS_R, WS_TGS = WS_R + 16 * MiB;
static_assert((size_t)M * FF * 2 == 176 * MiB && WS_H == 708 * MiB, "ws map");
constexpr int CW_BAR = 4096, CW_QUAD = 8192;

constexpr int RING_OFF = 0, RING_BYTES = 131072;
constexpr int LDSCTL_OFF = RING_BYTES, MISC_OFF = LDSCTL_OFF + 320;
constexpr int LDS_BYTES = 147456;
static_assert(MISC_OFF + 128 <= LDS_BYTES, "LDS map");

#define GAS __attribute__((address_space(1)))
#define LAS __attribute__((address_space(3)))
typedef unsigned short bf16;
typedef unsigned v4u __attribute__((ext_vector_type(4)));
typedef unsigned v2u __attribute__((ext_vector_type(2)));
typedef float f32x4 __attribute__((ext_vector_type(4)));
typedef short bf16x8 __attribute__((ext_vector_type(8)));
typedef GAS unsigned gu32;
#define RLX_AGENT __ATOMIC_RELAXED, __HIP_MEMORY_SCOPE_AGENT
#define LDS_WAIT() asm volatile("s_waitcnt lgkmcnt(0)" ::: "memory")
#define VM_WAIT() asm volatile("s_waitcnt vmcnt(0)" ::: "memory")
__device__ __forceinline__ unsigned f2bf(float f) { unsigned u = __builtin_bit_cast(unsigned, f); return (u + 0x7fffu + ((u >> 16) & 1u)) >> 16; }
__device__ __forceinline__ unsigned pk2(float lo, float hi) { return pg8::cvt_pk_bf16(lo, hi); }
__device__ __forceinline__ float bflo(unsigned w) { return __uint_as_float(w << 16); }
__device__ __forceinline__ float bfhi(unsigned w) { return __uint_as_float(w & 0xffff0000u); }

#define XB_TMO      128
#define XB_XCNT(j)  (256  + 64 * (j))
#define XB_XSUB(j)  (1280 + 64 * (j))
#define XB_XGEN(j)  (2304 + 64 * (j))
#define XB_TOP      3328
#define XB_TOPGEN   3392
#define XCD_BAR_WORDS 3456
#define XB_PTOP(p)    (3456 + 128 * (p))
#define XB_PTOPGEN(p) (3520 + 128 * (p))
#define XB_SPIN_CAP (1u << 18)

__device__ __forceinline__ unsigned xb_ld(unsigned* p)              { return __hip_atomic_load(p, __ATOMIC_RELAXED, __HIP_MEMORY_SCOPE_AGENT); }
__device__ __forceinline__ unsigned xb_add(unsigned* p, unsigned v) { return __hip_atomic_fetch_add(p, v, __ATOMIC_RELAXED, __HIP_MEMORY_SCOPE_AGENT); }
__device__ __forceinline__ unsigned xb_xcc_id() { return (unsigned)__builtin_amdgcn_s_getreg((3 << 11) | 20) & 0xFu; }
#define XB_SPIN(cond, bar) do { unsigned _sp = 0; while (cond) { __builtin_amdgcn_s_sleep(1); \
    if ((++_sp & 255u) == 0u) { if (xb_ld(&(bar)[XB_TMO])) break; if (_sp > XB_SPIN_CAP) { atomicAdd(&(bar)[XB_TMO], 1u); break; } } } } while (0)

struct XcdBarrier {
    unsigned* bar; unsigned x;
    volatile LAS unsigned* st;
};
__device__ __forceinline__ XcdBarrier xcd_barrier_post(unsigned* bar, volatile LAS unsigned* st) {
    XcdBarrier b; b.bar = bar; b.x = xb_xcc_id(); b.st = st;
    if (threadIdx.x == 0) st[2] = xb_add(&bar[XB_XCNT(b.x)], 1u);
    return b;
}
__device__ __forceinline__ void xcd_barrier_complete(unsigned* bar, unsigned x, unsigned& nloc, unsigned& nx, unsigned& uni) {
    const unsigned G = gridDim.x * gridDim.y * gridDim.z;
    unsigned sum, cnt, mine, sp = 0u;
    for (;;) {
        sum = 0u; cnt = 0u; mine = 0u; uni = 1u;
#pragma unroll
        for (unsigned j = 0; j < 16; ++j) { const unsigned c = xb_ld(&bar[XB_XCNT(j)]); sum += c; cnt += (c > 0u) ? 1u : 0u; mine = (j == x) ? c : mine; if (c != (j < 8u ? 32u : 0u)) uni = 0u; }
        if (sum == G) break;
        __builtin_amdgcn_s_sleep(1);
        if ((++sp & 255u) == 0u) { if (xb_ld(&bar[XB_TMO])) break; if (sp > XB_SPIN_CAP) { atomicAdd(&bar[XB_TMO], 1u); break; } }
    }
    nloc = mine > 0u ? mine : 1u; nx = cnt > 0u ? cnt : 1u; if (sum != G) uni = 0u;
}
__device__ __forceinline__ void xcd_barrier(const XcdBarrier& b, const bool pair) {
    asm volatile("s_waitcnt vmcnt(0)" ::: "memory");
    __syncthreads();
    if (threadIdx.x == 0) {
        unsigned* bar = b.bar;
        __builtin_amdgcn_s_waitcnt(0);
        unsigned nloc = b.st[0], nx = b.st[1];
        if (nloc == 0u) { unsigned uni; xcd_barrier_complete(bar, b.x, nloc, nx, uni); b.st[0] = nloc; b.st[1] = nx; b.st[3] = uni; }
        const unsigned old = xb_add(&bar[XB_XSUB(b.x)], 1u);
        const unsigned gen = old / nloc;
        if (old + 1u == (gen + 1u) * nloc) {
            __builtin_amdgcn_fence(__ATOMIC_RELEASE, "agent");
            asm volatile("s_waitcnt vmcnt(0)" ::: "memory");
            if (!pair) {
            const unsigned og = xb_add(&bar[XB_TOP], 1u);
            const unsigned tg = og / nx;
            if (og + 1u == (tg + 1u) * nx) xb_add(&bar[XB_TOPGEN], 1u);
            else XB_SPIN(xb_ld(&bar[XB_TOPGEN]) == tg, bar);
            } else {
            unsigned* top = &bar[XB_PTOP(b.x >> 1)]; unsigned* tgen = &bar[XB_PTOPGEN(b.x >> 1)];
            const unsigned og = xb_add(top, 1u);
            const unsigned tg = og / 2u;
            if (og + 1u == (tg + 1u) * 2u) xb_add(tgen, 1u);
            else XB_SPIN(xb_ld(tgen) == tg, bar);
            }
            __builtin_amdgcn_fence(__ATOMIC_ACQUIRE, "agent");
            xb_add(&bar[XB_XGEN(b.x)], 1u);
            asm volatile("s_waitcnt vmcnt(0)" ::: "memory");
        } else {
            XB_SPIN(xb_ld(&bar[XB_XGEN(b.x)]) == gen, bar);
            __builtin_amdgcn_fence(__ATOMIC_ACQUIRE, "agent");
            asm volatile("s_waitcnt vmcnt(0)" ::: "memory");
        }
    }
    __syncthreads();
}

__device__ __forceinline__ void quad_barrier(unsigned* cnt, unsigned* tmo) {
    asm volatile("s_waitcnt vmcnt(0)" ::: "memory");
    __syncthreads();
    if (threadIdx.x == 0) {
        __builtin_amdgcn_s_waitcnt(0);
        const unsigned old = xb_add(cnt, 1u), target = (old / 4u + 1u) * 4u;
        unsigned sp = 0;
        while (xb_ld(cnt) < target) { __builtin_amdgcn_s_sleep(1); if ((++sp & 255u) == 0u) { if (xb_ld(tmo)) break; if (sp > XB_SPIN_CAP) { atomicAdd(tmo, 1u); break; } } }
        __builtin_amdgcn_fence(__ATOMIC_ACQUIRE, "agent");
        asm volatile("s_waitcnt vmcnt(0)" ::: "memory");
    }
    __syncthreads();
}

struct Frame {
    LAS unsigned char* lds;
    volatile LAS unsigned* MISC;
    gu32* ctl;
    int vcu, G;
    int gx, gr, grp;
};
struct Lane { int tid, lane, wave; };
__device__ __forceinline__ Lane opaque_lane() { int t = threadIdx.x; asm volatile("" : "+v"(t)); Lane q; q.tid = t; q.lane = t & 63; q.wave = __builtin_amdgcn_readfirstlane(t >> 6); return q; }
__device__ __forceinline__ float wave_sum(float v) {
#pragma unroll
    for (int o = 1; o < 64; o <<= 1) v += __shfl_xor(v, o);
    return v;
}

__device__ __forceinline__ void p0_transpose_item(const float* __restrict__ W, int Ns, bf16* __restrict__ WT, int dld, int koff, int mode, LAS float* scr, int item, int lane) {
    const int nblk = Ns / 64, kb = item / nblk, nb = item % nblk, k0 = 64 * kb, n0 = 64 * nb;
    const int n0s = mode ? (((n0 >> 7) & 1) * FF + (n0 >> 8) * 128 + (n0 & 127)) : n0;
    const __amdgpu_buffer_rsrc_t rs = __builtin_amdgcn_make_buffer_rsrc((void*)W, 0, 0x7fffffff, 0x00020000);
    const int voff = (int)(((size_t)k0 * Ns + n0s + lane) * 4), rowb = Ns * 4;
    float wv[64];
#pragma unroll
    for (int k = 0; k < 64; ++k) wv[k] = __builtin_bit_cast(float, __builtin_amdgcn_raw_buffer_load_b32(rs, voff, k * rowb, W_AUX));
    LAS unsigned* scu = (LAS unsigned*)scr;
#pragma unroll
    for (int i = 0; i < 32; ++i) scu[i * 64 + (lane ^ (((i >> 2) & 3) << 3))] = pk2(wv[2 * i], wv[2 * i + 1]);
    LDS_WAIT(); asm volatile("" ::: "memory");
    const int rr = lane >> 2, ch = lane & 3;
#pragma unroll
    for (int j = 0; j < 8; ++j) { const int n = 16 * (j >> 1) + rr, kk = (j & 1) * 32 + 8 * ch; const LAS unsigned* sp = scu + (kk >> 1) * 64 + (n ^ (8 * ch));
        v4u o; o.x = sp[0 * 64]; o.y = sp[1 * 64]; o.z = sp[2 * 64]; o.w = sp[3 * 64];
        *(v4u*)((char*)WT + pg8::blk_byte(n0 + n, koff + k0 + kk, dld)) = o; }
    LDS_WAIT(); asm volatile("" ::: "memory");
}

struct Args { const float* in[20]; float* out; unsigned char* ws; int ph_lo, ph_hi; };

template <int MODE>
__device__ __forceinline__ void p0_items(Frame& F, const Args& args, int lsel) {
    const Lane T = opaque_lane();
    LAS float* scr = (LAS float*)(F.lds + RING_OFF + T.wave * 16384);
    const int gw = F.vcu * NWAVES + T.wave, NGW = F.G * NWAVES;
    constexpr int I_UP = (D / 64) * (NUP / 64), I_DN = (FF / 64) * (D / 64), I_IN = (D / 64) * (NIN / 64), I_G = 4 * 256 * 256 / 2048, I_WS = 8 * 128 * 128 / 2048, I_PO = (PW / 64) * (D / 64), I_SO = I_PO, I_O = (D / 64) * (D / 64);
    constexpr int PER_LAYER = 2 * I_UP + 2 * I_DN + I_IN + I_G + I_WS + I_PO + I_SO + I_O;
    constexpr int OFF_G = I_UP + I_DN + I_IN, OFF_PO = OFF_G + I_G + I_WS, I_SMALL = I_G + I_PO;
    constexpr int NITEMS = MODE == 0 ? PER_LAYER + (NL - 1) * I_SMALL : PER_LAYER - I_SMALL;
    for (int it = gw; it < NITEMS; it += NGW) {
        int l, r;
        if constexpr (MODE == 0) { if (it < PER_LAYER) { l = 0; r = it; } else { const int j = it - PER_LAYER, q = j % I_SMALL; l = 1 + j / I_SMALL; r = q < I_G ? OFF_G + q : OFF_PO + (q - I_G); } }
        else { l = lsel; r = it; if (r >= OFF_G) r += I_G; if (r >= OFF_PO) r += I_PO; }
        unsigned char* wl = args.ws + WS_W + (size_t)l * LW_STRIDE;
        if (r < I_UP) { p0_transpose_item(args.in[2] + (size_t)l * D * NUP, NUP, (bf16*)(wl + LW_UP1), D, 0, 1, scr, r, T.lane); continue; } r -= I_UP;
        if (r < I_DN) { p0_transpose_item(args.in[3] + (size_t)l * FF * D, D, (bf16*)(wl + LW_DN1), FF, 0, 0, scr, r, T.lane); continue; } r -= I_DN;
        if (r < I_IN) { p0_transpose_item(args.in[6] + (size_t)l * D * NIN, NIN, (bf16*)(wl + LW_WIN), D, 0, 0, scr, r, T.lane); continue; } r -= I_IN;
        if (r < I_G)  {
                        const float* src = args.in[7] + (size_t)l * 262144 + (size_t)r * 2048; const float* sc = args.in[8] + (size_t)l * PW + (r >> 5) * 256 + 4 * T.lane;
                        const f32x4 sv = *(const f32x4*)sc;
#pragma unroll
                        for (int p = 0; p < 8; ++p) { const f32x4 v = *(const f32x4*)(src + p * 256 + 4 * T.lane) * sv; v2u o; o.x = pk2(v.x, v.y); o.y = pk2(v.z, v.w);
                            *(v2u*)((char*)(args.ws + WS_TGS + (size_t)l * (MiB / 2)) + pg8::blk_byte(8 * r + p, 4 * T.lane, 256)) = o; }
                        continue; } r -= I_G;
        if (r < I_WS) {
                        const float* src = args.in[11] + (size_t)l * 131072 + (size_t)r * 2048; bf16* dst = (bf16*)(wl + LW_WG) + (size_t)r * 2048;
#pragma unroll
                        for (int p = 0; p < 8; ++p) { const int t = (16 * r + 2 * p + (T.lane >> 5)) & 127, s0 = (4 * T.lane) & 127; const f32x4 v = *(const f32x4*)(src + p * 256 + 4 * T.lane);
                            v2u o; o.x = pk2(s0 <= t ? v.x : 0.f, s0 + 1 <= t ? v.y : 0.f); o.y = pk2(s0 + 2 <= t ? v.z : 0.f, s0 + 3 <= t ? v.w : 0.f); *(v2u*)(dst + p * 256 + 4 * T.lane) = o; }
                        continue; } r -= I_WS;
        if (r < I_PO) { p0_transpose_item(args.in[9] + (size_t)l * PW * D, D, (bf16*)(args.ws + WS_TPO + (size_t)l * 4 * MiB), 1024, 0, 0, scr, r, T.lane); continue; } r -= I_PO;
        if (r < I_SO) { p0_transpose_item(args.in[13] + (size_t)l * SW * D, D, (bf16*)(wl + LW_WPS), 2048, 1024, 0, scr, r, T.lane); continue; } r -= I_SO;
        if (r < I_O)  { p0_transpose_item(args.in[14] + (size_t)l * D * D, D, (bf16*)(wl + LW_WO), D, 0, 0, scr, r, T.lane); continue; } r -= I_O;
        if (r < I_UP) { p0_transpose_item(args.in[17] + (size_t)l * D * NUP, NUP, (bf16*)(wl + LW_UP2), D, 0, 1, scr, r, T.lane); continue; } r -= I_UP;
        p0_transpose_item(args.in[18] + (size_t)l * FF * D, D, (bf16*)(wl + LW_DN2), FF, 0, 0, scr, r, T.lane);
    }
    __syncthreads();
}

typedef _Float16 h16x2 __attribute__((ext_vector_type(2)));
typedef float f32x2_t __attribute__((ext_vector_type(2)));
__device__ __forceinline__ unsigned pk_h2(float a, float b) { const h16x2 h = __builtin_convertvector((f32x2_t){a, b}, h16x2); return __builtin_bit_cast(unsigned, h); }
__device__ __forceinline__ f32x2_t un_h2(unsigned w) { return __builtin_convertvector(__builtin_bit_cast(h16x2, w), f32x2_t); }
template <bool XIN_BF, bool XOUT_BF>
__device__ __forceinline__ void norm_phase(Frame& F, const void* xin_, void* xout_, const bf16* Fb, const float* gpost, float wgt, const float* gnext, bf16* H) {
    const float* xin = (const float*)xin_; float* xout = (float*)xout_; const bf16* xinb = (const bf16*)xin_; bf16* xoutb = (bf16*)xout_;
    const Lane T = opaque_lane();
    const int gw = F.vcu * NWAVES + T.wave, NGW = F.G * NWAVES, lw = 256 * (F.gr & 7) + 64 * (F.gr >> 3) + T.wave;
#define NORM_ROW(i) (F.grp ? (2048 * F.gx + lw + 8 * (i)) : (gw + NGW * (i)))
    const int nrows = F.grp ? 8 : (M - gw + NGW - 1) / NGW;
    f32x4 gp[8], gn[8];
#pragma unroll
    for (int j = 0; j < 8; ++j) { gp[j] = Fb ? ((const f32x4*)gpost)[64 * j + T.lane] : (f32x4){0.f, 0.f, 0.f, 0.f}; gn[j] = gnext ? ((const f32x4*)gnext)[64 * j + T.lane] : (f32x4){0.f, 0.f, 0.f, 0.f}; }
    f32x4 x[8], xn[8]; v2u fw[8], fn[8], xbn[8];
    { const int m = NORM_ROW(0);
      if constexpr (XIN_BF) { const v2u* xr = (const v2u*)(xinb + (size_t)m * D) + T.lane;
#pragma unroll
          for (int j = 0; j < 8; ++j) xbn[j] = __builtin_nontemporal_load(xr + 64 * j); }
      else { const f32x4* xr = (const f32x4*)(xin + (size_t)m * D) + T.lane;
#pragma unroll
          for (int j = 0; j < 8; ++j) xn[j] = __builtin_nontemporal_load(xr + 64 * j); }
      if (Fb) { const v2u* fr = (const v2u*)(Fb + (size_t)m * D) + T.lane;
#pragma unroll
          for (int j = 0; j < 8; ++j) fn[j] = __builtin_nontemporal_load(fr + 64 * j); } }
    for (int i = 0; i < nrows; ++i) {
        const int m = NORM_ROW(i);
#pragma unroll
        for (int j = 0; j < 8; ++j) { if constexpr (XIN_BF) { const v2u w = xbn[j]; const f32x2_t a = un_h2(w.x), b = un_h2(w.y); x[j] = (f32x4){a.x, a.y, b.x, b.y}; } else x[j] = xn[j]; fw[j] = fn[j]; }
        if (i + 1 < nrows) { const int m2 = NORM_ROW(i + 1);
            if constexpr (XIN_BF) { const v2u* xr = (const v2u*)(xinb + (size_t)m2 * D) + T.lane;
#pragma unroll
                for (int j = 0; j < 8; ++j) xbn[j] = __builtin_nontemporal_load(xr + 64 * j); }
            else { const f32x4* xr = (const f32x4*)(xin + (size_t)m2 * D) + T.lane;
#pragma unroll
                for (int j = 0; j < 8; ++j) xn[j] = __builtin_nontemporal_load(xr + 64 * j); }
            if (Fb) { const v2u* fr = (const v2u*)(Fb + (size_t)m2 * D) + T.lane;
#pragma unroll
                for (int j = 0; j < 8; ++j) fn[j] = __builtin_nontemporal_load(fr + 64 * j); } }
        if (Fb) {
            f32x4 f[8]; float ss = 0.f;
#pragma unroll
            for (int j = 0; j < 8; ++j) { const v2u w = fw[j]; f[j] = (f32x4){bflo(w.x), bfhi(w.x), bflo(w.y), bfhi(w.y)}; ss += (f[j].x * f[j].x + f[j].y * f[j].y) + (f[j].z * f[j].z + f[j].w * f[j].w); }
            const float rs = wgt * __builtin_amdgcn_rsqf(wave_sum(ss) * (1.f / D) + EPS);
            if constexpr (XOUT_BF) { v2u* xo = (v2u*)(xoutb + (size_t)m * D) + T.lane;
#pragma unroll
                for (int j = 0; j < 8; ++j) { x[j] = x[j] + (f[j] * rs) * gp[j]; v2u w; w.x = pk_h2(x[j].x, x[j].y); w.y = pk_h2(x[j].z, x[j].w); __builtin_nontemporal_store(w, xo + 64 * j); } }
            else { f32x4* xo = (f32x4*)(xout + (size_t)m * D) + T.lane;
#pragma unroll
                for (int j = 0; j < 8; ++j) { x[j] = x[j] + (f[j] * rs) * gp[j]; __builtin_nontemporal_store(x[j], xo + 64 * j); } }
        }
        if (gnext) {
            float s2 = 0.f;
#pragma unroll
            for (int j = 0; j < 8; ++j) s2 += (x[j].x * x[j].x + x[j].y * x[j].y) + (x[j].z * x[j].z + x[j].w * x[j].w);
            const float rx = __builtin_amdgcn_rsqf(wave_sum(s2) * (1.f / D) + EPS);
#pragma unroll
            for (int j = 0; j < 8; ++j) { const f32x4 v = (x[j] * rx) * gn[j]; v2u w; w.x = pg8::cvt_pk_bf16(v.x, v.y); w.y = pg8::cvt_pk_bf16(v.z, v.w);
                *(v2u*)((char*)H + pg8::blk_byte(m, 256 * j + 4 * T.lane, D)) = w; }
        }
    }
#undef NORM_ROW
}

template <int W> __device__ __forceinline__ void pool_body(const bf16* __restrict__ P, bf16* __restrict__ DP, int ms, int c0) {
    const int tl0 = ms & (SEQ - 1);
    v4u row[W - 1 + 16];
#pragma unroll
    for (int k = 0; k < W - 1; ++k) { const int j = W - 1 - k; row[k] = (tl0 - j >= 0) ? __builtin_nontemporal_load((const v4u*)(P + (size_t)(ms - j) * PW + c0)) : (v4u){0u, 0u, 0u, 0u}; }
#pragma unroll
    for (int i = 0; i < 16; ++i) row[W - 1 + i] = __builtin_nontemporal_load((const v4u*)(P + (size_t)(ms + i) * PW + c0));
    float S[8];
#pragma unroll
    for (int k = 0; k < 8; ++k) S[k] = 0.f;
#pragma unroll
    for (int k = 0; k < W - 1; ++k)
#pragma unroll
        for (int q = 0; q < 4; ++q) { S[2 * q] += bflo(row[k][q]); S[2 * q + 1] += bfhi(row[k][q]); }
#pragma unroll
    for (int i = 0; i < 16; ++i) {
        float cur[8], d[8];
#pragma unroll
        for (int q = 0; q < 4; ++q) { cur[2 * q] = bflo(row[W - 1 + i][q]); cur[2 * q + 1] = bfhi(row[W - 1 + i][q]); }
        const int cnt = (tl0 + i + 1) < W ? (tl0 + i + 1) : W; const float inv = 1.0f / (float)cnt;
#pragma unroll
        for (int k = 0; k < 8; ++k) { S[k] += cur[k]; d[k] = S[k] * inv - cur[k]; }
        v4u o; o.x = pg8::cvt_pk_bf16(d[0], d[1]); o.y = pg8::cvt_pk_bf16(d[2], d[3]); o.z = pg8::cvt_pk_bf16(d[4], d[5]); o.w = pg8::cvt_pk_bf16(d[6], d[7]);
        *(v4u*)((char*)DP + pg8::blk_byte(ms + i, c0, 2048)) = o;
#pragma unroll
        for (int q = 0; q < 4; ++q) { S[2 * q] -= bflo(row[i][q]); S[2 * q + 1] -= bfhi(row[i][q]); }
    }
}
__device__ __forceinline__ void pool_unit(Frame& F, const bf16* __restrict__ P, bf16* __restrict__ DP, int unit) {
    const Lane T = opaque_lane();
    const int g = T.wave & 3, tq = 2 * (T.wave >> 2) + (T.lane >> 5), c0 = g * 256 + (T.lane & 31) * 8, ms = unit * 64 + tq * 16;
    if (g == 0) pool_body<2>(P, DP, ms, c0); else if (g == 1) pool_body<4>(P, DP, ms, c0); else if (g == 2) pool_body<8>(P, DP, ms, c0); else pool_body<16>(P, DP, ms, c0);
}

__device__ __forceinline__ void sgu_unit(Frame& F, const bf16* __restrict__ VT, const bf16* __restrict__ U, bf16* __restrict__ YZ, const float* __restrict__ SSQ, const bf16* __restrict__ WSB,
                                         const float* __restrict__ bs, const float* __restrict__ gain, int unit) {
    const Lane T = opaque_lane();
    const int hg = unit & 1, cn = unit >> 1, m0 = cn * 128;
    LAS float* rstd = (LAS float*)(F.lds + RING_OFF);
    if (T.tid < 128) { float sm = 0.f;
#pragma unroll
        for (int k = 0; k < 8; ++k) sm += SSQ[(size_t)k * M + m0 + T.tid];
        rstd[T.tid] = __builtin_amdgcn_rsqf(sm * (1.f / SW) + EPS); }
    __syncthreads();
    const int fr = T.lane & 15, fq = T.lane >> 4;
    float rs[4][8];
#pragma unroll
    for (int ks = 0; ks < 4; ++ks) { const f32x4 a = *(const LAS f32x4*)(rstd + ks * 32 + 8 * fq), b = *(const LAS f32x4*)(rstd + ks * 32 + 8 * fq + 4);
#pragma unroll
        for (int i = 0; i < 4; ++i) { rs[ks][i] = a[i]; rs[ks][4 + i] = b[i]; } }
    __syncthreads();
    const int h = hg * 4 + (T.wave >> 1);
    const bf16* Wh = WSB + (size_t)h * 16384;
    float bias[8];
#pragma unroll
    for (int jt = 0; jt < 8; ++jt) bias[jt] = bs[h * 128 + 16 * jt + fr];
#pragma unroll
    for (int pr = 0; pr < 2; ++pr) {
        const int cb = h * 128 + (T.wave & 1) * 64 + pr * 32, chA = cb + 8 * (fr >> 2) + (fr & 3);
        bf16x8 xa[4], xb[4];
#pragma unroll
        for (int ks = 0; ks < 4; ++ks) { const v4u qa = __builtin_nontemporal_load((const v4u*)(VT + (size_t)chA * M + m0 + ks * 32 + 8 * fq)), qb = __builtin_nontemporal_load((const v4u*)(VT + (size_t)(chA + 4) * M + m0 + ks * 32 + 8 * fq));
            v4u oa, ob;
#pragma unroll
            for (int k = 0; k < 4; ++k) { oa[k] = pg8::cvt_pk_bf16(bflo(qa[k]) * rs[ks][2 * k], bfhi(qa[k]) * rs[ks][2 * k + 1]); ob[k] = pg8::cvt_pk_bf16(bflo(qb[k]) * rs[ks][2 * k], bfhi(qb[k]) * rs[ks][2 * k + 1]); }
            xa[ks] = __builtin_bit_cast(bf16x8, oa); xb[ks] = __builtin_bit_cast(bf16x8, ob); }
        f32x4 accA[8], accB[8];
#pragma unroll
        for (int jt = 0; jt < 8; ++jt) { accA[jt] = (f32x4){0.f, 0.f, 0.f, 0.f}; accB[jt] = (f32x4){0.f, 0.f, 0.f, 0.f};
#pragma unroll
            for (int ks = 0; ks < 4; ++ks) if (32 * ks <= 16 * jt + 15) { const bf16x8 yf = *(const bf16x8*)(Wh + (16 * jt + fr) * 128 + ks * 32 + 8 * fq);
                accA[jt] = __builtin_amdgcn_mfma_f32_16x16x32_bf16(xa[ks], yf, accA[jt], 0, 0, 0); accB[jt] = __builtin_amdgcn_mfma_f32_16x16x32_bf16(xb[ks], yf, accB[jt], 0, 0, 0); } }
        const int c8 = cb + 8 * fq; const f32x4 ga = *(const f32x4*)(gain + c8), gb = *(const f32x4*)(gain + c8 + 4);
#pragma unroll
        for (int jt = 0; jt < 8; ++jt) { const size_t m = (size_t)(m0 + 16 * jt + fr); const v4u uu = __builtin_nontemporal_load((const v4u*)(U + m * SW + c8)); const float b = bias[jt];
            v4u o;
            o.x = pg8::cvt_pk_bf16(bflo(uu.x) * (accA[jt][0] * ga[0] + b), bfhi(uu.x) * (accA[jt][1] * ga[1] + b)); o.y = pg8::cvt_pk_bf16(bflo(uu.y) * (accA[jt][2] * ga[2] + b), bfhi(uu.y) * (accA[jt][3] * ga[3] + b));
            o.z = pg8::cvt_pk_bf16(bflo(uu.z) * (accB[jt][0] * gb[0] + b), bfhi(uu.z) * (accB[jt][1] * gb[1] + b)); o.w = pg8::cvt_pk_bf16(bflo(uu.w) * (accB[jt][2] * gb[2] + b), bfhi(uu.w) * (accB[jt][3] * gb[3] + b));
            *(v4u*)((char*)YZ + pg8::blk_byte((int)m, 1024 + c8, 2048)) = o; }
    }
}

#ifndef PG8_SP2
#define PG8_SP2 true
#endif
#ifndef PG8_ALIGN
#define PG8_ALIGN true
#endif

__global__ void __launch_bounds__(NWAVES * 64, 2) mk_fwd(Args args) {
    extern __shared__ __attribute__((aligned(16))) unsigned char lds[];
    Frame F;
    F.lds = (LAS unsigned char*)lds;
    F.MISC = (volatile LAS unsigned*)(F.lds + MISC_OFF);
    F.G = gridDim.x; { const int bx = blockIdx.x; F.vcu = (F.G % 8 == 0) ? (bx % 8) * (F.G / 8) + bx / 8 : bx; }
    unsigned char* ws = args.ws;
    F.ctl = (gu32*)(ws + WS_CTL);
    for (int u = threadIdx.x; u < (LDS_BYTES - LDSCTL_OFF) / 4; u += NWAVES * 64) ((LAS unsigned*)(F.lds + LDSCTL_OFF))[u] = 0u;
    __syncthreads();
    const int lo = args.ph_lo, hi = args.ph_hi;
    XcdBarrier bar; bar.bar = (unsigned*)(F.ctl + CW_BAR); bar.x = 0; bar.st = nullptr;
    if (hi - lo > 1) bar = xcd_barrier_post((unsigned*)(F.ctl + CW_BAR), F.MISC + 8);
#define IN(k) (lo <= (k) && (k) < hi)
#define SEAM_G(k) do { if (IN(k) && IN((k) + 1)) xcd_barrier(bar, false); } while (0)
#define SEAM_P(k) do { if (IN(k) && IN((k) + 1)) xcd_barrier(bar, lmode); } while (0)
#define SEAM_L(k) do { if (IN(k) && IN((k) + 1)) { if (lmode) quad_barrier(qcnt, (unsigned*)(F.ctl + CW_BAR) + XB_TMO); else xcd_barrier(bar, false); } } while (0)
    unsigned* qcnt = (unsigned*)(F.ctl + CW_QUAD);
    F.gx = (int)blockIdx.x & 7; F.gr = (int)blockIdx.x >> 3; F.grp = 0;
    bool lmode = false; int cid = (int)blockIdx.x;

    bf16* const Hb = (bf16*)(ws + WS_H); bf16* const Fb = (bf16*)(ws + WS_F); bf16* const ACT = (bf16*)(ws + WS_ACT);
    bf16* const XB = (bf16*)(ws + WS_XB);
    bf16* const Ub = (bf16*)(ws + WS_U); bf16* const VT = (bf16*)(ws + WS_VT);
    bf16* const SGA = (bf16*)(ws + WS_SGA); bf16* const SGB = (bf16*)(ws + WS_SGB); bf16* const YZ = (bf16*)(ws + WS_YZ); bf16* const MM = (bf16*)(ws + WS_MM);

    if (IN(0)) { p0_items<0>(F, args, 0); norm_phase<false, true>(F, args.in[0], nullptr, nullptr, nullptr, 0.f, args.in[1], Hb); }
    SEAM_G(0);
    if (hi - lo > 1) {
        const unsigned rk = F.MISC[10], uni = F.MISC[11];
        lmode = (__builtin_amdgcn_readfirstlane(uni) == 1u) && F.G == 256 && !MK_FORCE_GRID_BARRIERS;
        if (lmode) { F.gx = (int)bar.x; F.gr = (int)__builtin_amdgcn_readfirstlane(rk); cid = F.gr * 8 + F.gx; qcnt += 64 * (F.gx * 8 + (F.gr & 7)); }
    }
    F.grp = (F.G == 256);
    const int myslot = (lmode ? (F.gr & 7) : (cid & 7)) & 3;
#define CONV(q) do { if (l + 1 < NL && myslot == (q)) p0_items<1>(F, args, l + 1); } while (0)
    if (IN(1)) {
        const int fl = (int)blockIdx.x >> 5;
        if (fl < NL) {
            pg8::Gemm g{(const bf16*)(ws + WS_TPO + (size_t)fl * 4 * MiB), (const bf16*)(ws + WS_TGS + (size_t)fl * (MiB / 2)), D, PW, 256, PW, 256, 256}; g.base = (const char*)ws; pg8::StaticOrder S; S.init(D, PW, 32, (int)blockIdx.x & 31);
            pg8::EpiBf16S E{(bf16*)(ws + WS_W + (size_t)fl * LW_STRIDE + LW_WPS), 2048, nullptr, 1};
            pg8::gemm_phase<pg8::EpiBf16S, pg8::StaticOrder, PG8_ALIGN, PG8_SP2>(F.lds + RING_OFF, g, S, E);
        }
    }
    SEAM_G(1);
    if (lmode && STAGGER_US > 0) { const unsigned long long t0 = __builtin_amdgcn_s_memrealtime(), dt = (unsigned long long)(F.gx >> 1) * STAGGER_US * 100ull;
        while (__builtin_amdgcn_s_memrealtime() - t0 < dt) __builtin_amdgcn_s_sleep(8); }

    for (int s = 0; s < 2 * NL; ++s) {
        const int l = s >> 1, second = s & 1, pb = 2 + 11 * l + (second ? 8 : 0);
        unsigned char* wl = ws + WS_W + (size_t)l * LW_STRIDE;
        if (IN(pb)) {
            if (second) CONV(2);
            pg8::Gemm g{Hb, (const bf16*)(wl + (second ? LW_UP2 : LW_UP1)), M, NUP, D, D, D, 0}; g.base = (const char*)ws; pg8::StaticOrder S; S.init(M, NUP, F.G, cid);
            pg8::EpiSwiGLU E{ACT, FF};
            pg8::gemm_phase<pg8::EpiSwiGLU, pg8::StaticOrder, PG8_ALIGN, PG8_SP2>(F.lds + RING_OFF, g, S, E);
        }
        SEAM_L(pb);
        if (IN(pb + 1)) {
            if (second) CONV(3);
            pg8::Gemm g{ACT, (const bf16*)(wl + (second ? LW_DN2 : LW_DN1)), M, D, FF, FF, FF, 0}; g.base = (const char*)ws; pg8::StaticOrder S; S.init(M, D, F.G, cid);
            pg8::EpiBf16S E{Fb, D, nullptr, 0};
            pg8::gemm_phase<pg8::EpiBf16S, pg8::StaticOrder, PG8_ALIGN, PG8_SP2>(F.lds + RING_OFF, g, S, E);
        }
        SEAM_L(pb + 1);
        if (IN(pb + 2)) {
            const float* gpost = (second ? args.in[19] : args.in[4]) + (size_t)l * D;
            const float* gnext = second ? (l + 1 < NL ? args.in[1] + (size_t)(l + 1) * D : nullptr) : args.in[5] + (size_t)l * D;
            if (s == 0) norm_phase<false, true>(F, args.in[0], XB, Fb, gpost, 0.5f, gnext, Hb);
            else if (s == 2 * NL - 1) norm_phase<true, false>(F, XB, args.out, Fb, gpost, 0.5f, gnext, Hb);
            else norm_phase<true, true>(F, XB, XB, Fb, gpost, 0.5f, gnext, Hb);
        }
        if (second && l + 1 < NL) SEAM_G(pb + 2); else SEAM_L(pb + 2);
        if (!second) {
            if (IN(pb + 3)) {
                pg8::Gemm g{Hb, (const bf16*)(wl + LW_WIN), M, NIN, D, D, D, 0}; g.base = (const char*)ws; pg8::StaticOrder S; S.init(M, NIN, F.G, cid);
                pg8::EpiInProj E{(bf16*)(ws + ((l & 1) ? WS_P1 : WS_P)), Ub, VT, SGA, SGB, M, (float*)(ws + WS_SSQ)};
                pg8::gemm_phase<pg8::EpiInProj, pg8::StaticOrder, PG8_ALIGN, PG8_SP2>(F.lds + RING_OFF, g, S, E);
            }
            SEAM_P(pb + 3);
            if (IN(pb + 4)) {
                CONV(0);
                const int u0 = F.grp ? 32 * F.gx + 4 * (F.gr & 7) + (F.gr >> 3) : F.vcu;
                for (int u = u0; u < M / 64; u += F.G) pool_unit(F, (const bf16*)(ws + ((l & 1) ? WS_P1 : WS_P)), YZ, u);
                for (int u = u0; u < 2 * (M / 128); u += F.G)
                    sgu_unit(F, VT, Ub, YZ, (const float*)(ws + WS_SSQ), (const bf16*)(wl + LW_WG), args.in[12] + (size_t)l * 8 * 128, args.in[10] + (size_t)l * SW, u);
            }
            SEAM_L(pb + 4);
            if (IN(pb + 5)) {
                pg8::Gemm g{YZ, (const bf16*)(wl + LW_WPS), M, D, 2048, 2048, 2048, 0}; g.base = (const char*)ws; pg8::StaticOrder S; S.init(M, D, F.G, cid);
                pg8::EpiGate E{SGA, SGB, MM};
                pg8::gemm_phase<pg8::EpiGate, pg8::StaticOrder, PG8_ALIGN, PG8_SP2>(F.lds + RING_OFF, g, S, E);
            }
            SEAM_L(pb + 5);
            if (IN(pb + 6)) {
                CONV(1);
                pg8::Gemm g{MM, (const bf16*)(wl + LW_WO), M, D, D, D, D, 0}; g.base = (const char*)ws; pg8::StaticOrder S; S.init(M, D, F.G, cid);
                pg8::EpiBf16S E{Fb, D, nullptr, 0};
                pg8::gemm_phase<pg8::EpiBf16S, pg8::StaticOrder, PG8_ALIGN, PG8_SP2>(F.lds + RING_OFF, g, S, E);
            }
            SEAM_L(pb + 6);
            if (IN(pb + 7)) norm_phase<true, true>(F, XB, XB, Fb, args.in[15] + (size_t)l * D, 1.0f, args.in[16] + (size_t)l * D, Hb);
            SEAM_L(pb + 7);
        }
    }
#undef IN
#undef SEAM_G
#undef SEAM_P
#undef SEAM_L
#undef CONV
}

extern "C" void kernel_launch(void* const* d_in, const int* in_sizes, int n_in, void* d_out, int out_size, void* d_ws, size_t ws_size, hipStream_t stream) {
    static int grid = 0;
    if (grid == 0) {
        if (n_in != 20 || in_sizes[0] != M * D || out_size != M * D || ws_size < WS_END) { fprintf(stderr, "kernel_launch: shape/workspace mismatch: n_in %d in0 %d out %d ws %zu (need %zu)\n", n_in, n_in > 0 ? in_sizes[0] : -1, out_size, ws_size, (size_t)WS_END); grid = -1; return; }
        int dev = 0, cus = 0, per_cu = 0;
        if (hipGetDevice(&dev) != hipSuccess || hipDeviceGetAttribute(&cus, hipDeviceAttributeMultiprocessorCount, dev) != hipSuccess) { fprintf(stderr, "kernel_launch: device query failed\n"); grid = -1; return; }
        if (hipFuncSetAttribute((const void*)mk_fwd, hipFuncAttributeMaxDynamicSharedMemorySize, LDS_BYTES) != hipSuccess) { fprintf(stderr, "kernel_launch: hipFuncSetAttribute failed\n"); grid = -1; return; }
        if (hipOccupancyMaxActiveBlocksPerMultiprocessor(&per_cu, (const void*)mk_fwd, NWAVES * 64, LDS_BYTES) != hipSuccess || per_cu < 1) { fprintf(stderr, "kernel_launch: occupancy query reports %d workgroups per CU\n", per_cu); per_cu = 1; }
        (void)hipGetLastError();
        grid = cus;
    }
    if (grid < 0) return;
    if (hipMemsetAsync((char*)d_ws + WS_CTL, 0, CTL_ZERO_BYTES, stream) != hipSuccess) { fprintf(stderr, "kernel_launch: memset failed\n"); return; }
    Args a{};
    for (int i = 0; i < 20; ++i) a.in[i] = (const float*)d_in[i];
    a.out = (float*)d_out; a.ws = (unsigned char*)d_ws;
#if MK_ONE_LAUNCH
    a.ph_lo = 0; a.ph_hi = N_PHASES;
    hipLaunchKernelGGL(mk_fwd, dim3(grid), dim3(NWAVES * 64), LDS_BYTES, stream, a);
#else
    for (int p = 0; p < N_PHASES; ++p) { a.ph_lo = p; a.ph_hi = p + 1; hipLaunchKernelGGL(mk_fwd, dim3(grid), dim3(NWAVES * 64), LDS_BYTES, stream, a); }
#endif
    const hipError_t le = hipPeekAtLastError();
    if (le != hipSuccess) fprintf(stderr, "kernel_launch: launch failed: %s\n", hipGetErrorName(le));
}
```

```cpp
#include <hip/hip_runtime.h>
#include <cstdio>
#include <cstdint>

#ifndef STAGGER_US
#define STAGGER_US 0
#endif
#ifndef MK_FORCE_GRID_BARRIERS
#define MK_FORCE_GRID_BARRIERS 0
#endif
#ifndef W_AUX
#define W_AUX 19
#endif
#ifndef MK_ONE_LAUNCH
#define MK_ONE_LAUNCH 1
#endif

namespace pg8 {
#define PG8_LAS __attribute__((address_space(3)))
typedef unsigned short bf16_t;
typedef short bf16x8 __attribute__((ext_vector_type(8)));
typedef float f32x4 __attribute__((ext_vector_type(4)));
typedef float f32x2 __attribute__((ext_vector_type(2)));
typedef unsigned u32x4 __attribute__((ext_vector_type(4)));
typedef unsigned u32x2 __attribute__((ext_vector_type(2)));
constexpr int BM = 256, BK = 64, HALF = 128, HTB = HALF * BK * 2  , STAGE_BYTES = 8 * HTB, NXCD = 8, WGM = 8;

__host__ __device__ __forceinline__ int lds_byte(int r, int c) { const int st = (r >> 4) * 2 + (c >> 5), rr = r & 15, cc = c & 31, ob = rr * 64 + cc * 2; return st * 1024 + (ob ^ (((ob >> 9) & 1) << 5)); }
__host__ __device__ __forceinline__ void stage_rc(int b, int& R, int& C) { const int st = b / 1024, sb = b % 1024, swz = sb ^ (((sb >> 9) & 1) << 5); R = (st >> 1) * 16 + swz / 64; C = (st & 1) * 32 + (swz % 64) / 2; }
__host__ __device__ __forceinline__ int perm32(int rho) { const int n = rho >> 4, i = rho & 15; return 8 * (i >> 2) + 4 * n + (i & 3); }

__host__ __device__ __forceinline__ size_t blk_byte(int r, int c, int K) { return ((size_t)(r >> 7) * (size_t)(K >> 6) + (size_t)(c >> 6)) * 16384 + (size_t)lds_byte(r & 127, c & 63); }
struct Unit { int pm, pn; };
struct Gemm { const bf16_t* A; const bf16_t* Bt; int M, N, K, lda, ldb, a_pn_koff; };

struct StaticOrder {
    int nM, nN, nwg, G, c;
    __host__ __device__ void init(int M, int N, int G_, int c_) { nM = M / BM; nN = N / BM; nwg = nM * nN; G = G_; c = c_; }
    __host__ __device__ bool next(int i, Unit& u) const {
        const long L = (long)i * G + c; if (L >= nwg) return false;
        int wgid = (int)L; { const int q = nwg / NXCD, r = nwg % NXCD, xcd = wgid % NXCD, off = wgid / NXCD; wgid = (xcd < r ? xcd * (q + 1) : r * (q + 1) + (xcd - r) * q) + off; }
        const int nig = WGM * nN, gid = wgid / nig, fm = gid * WGM, gsz = (nM - fm) < WGM ? (nM - fm) : WGM;
        u.pm = fm + ((wgid % nig) % gsz); u.pn = (wgid % nig) / gsz; return true;
    }
    __device__ __forceinline__ void a_ready(const Unit&) const {}
    __device__ __forceinline__ void done(const Unit&) const {}
};

__device__ __forceinline__ unsigned cvt_pk_bf16(float lo, float hi) { unsigned r; asm volatile("v_cvt_pk_bf16_f32 %0, %1, %2" : "=v"(r) : "v"(lo), "v"(hi)); return r; }
__device__ __forceinline__ float row16_sum(float v) {
    v += __builtin_bit_cast(float, __builtin_amdgcn_update_dpp(0, __builtin_bit_cast(int, v), 0xB1, 0xF, 0xF, true));
    v += __builtin_bit_cast(float, __builtin_amdgcn_update_dpp(0, __builtin_bit_cast(int, v), 0x4E, 0xF, 0xF, true));
    v += __builtin_bit_cast(float, __builtin_amdgcn_update_dpp(0, __builtin_bit_cast(int, v), 0x141, 0xF, 0xF, true));
    v += __builtin_bit_cast(float, __builtin_amdgcn_update_dpp(0, __builtin_bit_cast(int, v), 0x140, 0xF, 0xF, true));
    return v;
}
__device__ __forceinline__ float bf_lo(unsigned w) { return __uint_as_float(w << 16); }
__device__ __forceinline__ float bf_hi(unsigned w) { return __uint_as_float(w & 0xffff0000u); }
__device__ __forceinline__ float sigmoid_f(float x) { return __builtin_amdgcn_rcpf(1.0f + __builtin_amdgcn_exp2f(-1.4426950408889634f * x)); }
__device__ __forceinline__ float silu_f(float x) { return x * sigmoid_f(x); }
__device__ __forceinline__ float gelu_f(float x) { const float y = 1.5957691216057308f * (x + 0.044715f * x * x * x); return x * sigmoid_f(y); }
__device__ __forceinline__ f32x4 exp2_4(const f32x4 z) { return (f32x4){__builtin_amdgcn_exp2f(z[0]), __builtin_amdgcn_exp2f(z[1]), __builtin_amdgcn_exp2f(z[2]), __builtin_amdgcn_exp2f(z[3])}; }
__device__ __forceinline__ f32x4 rcp_4(const f32x4 d) { return (f32x4){__builtin_amdgcn_rcpf(d[0]), __builtin_amdgcn_rcpf(d[1]), __builtin_amdgcn_rcpf(d[2]), __builtin_amdgcn_rcpf(d[3])}; }
__device__ __forceinline__ f32x4 sigmoid_4(const f32x4 x) { return rcp_4(exp2_4(x * -1.4426950408889634f) + 1.0f); }
__device__ __forceinline__ f32x4 gelu_4(const f32x4 x) { const float c1 = -1.4426950408889634f * 1.5957691216057308f, c2 = c1 * 0.044715f; const f32x4 z = x * ((x * x) * c2 + c1); return x * rcp_4(exp2_4(z) + 1.0f); }
__device__ __forceinline__ f32x4 swiglu_4(const f32x4 g, const f32x4 u) { return (g * u) * sigmoid_4(g); }
__device__ __forceinline__ u32x4 pack8(const f32x4 v0, const f32x4 v1) { u32x4 w; w.x = cvt_pk_bf16(v0[0], v0[1]); w.y = cvt_pk_bf16(v0[2], v0[3]); w.z = cvt_pk_bf16(v1[0], v1[1]); w.w = cvt_pk_bf16(v1[2], v1[3]); return w; }

struct EpiSwiGLU {
    static constexpr bool PERM = true, AFTER_DRAIN = false, SWAP = false, MID = false;
    bf16_t* O; int ldc;
    __device__ __forceinline__ bool swapped(const Unit&) const { return false; }
    __device__ __forceinline__ void mid(f32x4 (&)[2][2][4][2], const Unit&, int, int, int, int) const {}
    __device__ __forceinline__ void operator()(const f32x4 (&acc)[2][2][4][2], const Unit& u, int wr, int wc, int fr, int fq) const {
        const int row0 = u.pm * BM + wr * 64 + fr, col0 = u.pn * HALF + wc * 32 + 8 * fq;
#pragma unroll
        for (int ai = 0; ai < 2; ++ai)
#pragma unroll
            for (int m = 0; m < 4; ++m) { bf16_t* rowp = (bf16_t*)((char*)O + blk_byte(row0 + ai * HALF + m * 16, col0, ldc));
                const f32x4 v0 = swiglu_4(acc[ai][0][m][0], acc[ai][1][m][0]), v1 = swiglu_4(acc[ai][0][m][1], acc[ai][1][m][1]);
                *(u32x4*)rowp = pack8(v0, v1); }
    }
};
struct EpiBf16S {
    static constexpr bool PERM = true, AFTER_DRAIN = false, SWAP = false, MID = false;
    bf16_t* O; int ldc; const float* scale; int tiled;
    __device__ __forceinline__ bool swapped(const Unit&) const { return false; }
    __device__ __forceinline__ void mid(f32x4 (&)[2][2][4][2], const Unit&, int, int, int, int) const {}
    __device__ __forceinline__ void operator()(const f32x4 (&acc)[2][2][4][2], const Unit& u, int wr, int wc, int fr, int fq) const {
        const int row0 = u.pm * BM + wr * 64 + fr, col0 = u.pn * BM + wc * 32 + 8 * fq;
        f32x4 sv[2][2];
#pragma unroll
        for (int bj = 0; bj < 2; ++bj)
#pragma unroll
            for (int n = 0; n < 2; ++n) sv[bj][n] = scale ? *(const f32x4*)(scale + col0 + bj * HALF + 4 * n) : (f32x4){1.f, 1.f, 1.f, 1.f};
#pragma unroll
        for (int ai = 0; ai < 2; ++ai)
#pragma unroll
            for (int m = 0; m < 4; ++m) { const int r = row0 + ai * HALF + m * 16;
#pragma unroll
                for (int bj = 0; bj < 2; ++bj) { bf16_t* p = tiled ? (bf16_t*)((char*)O + blk_byte(r, col0 + bj * HALF, ldc)) : O + (size_t)r * ldc + col0 + bj * HALF;
                    *(u32x4*)p = pack8(acc[ai][bj][m][0] * sv[bj][0], acc[ai][bj][m][1] * sv[bj][1]); } }
    }
};
struct EpiInProj {
    static constexpr bool PERM = true, AFTER_DRAIN = false, SWAP = true, MID = false;
    bf16_t *P, *U, *VT, *SGA, *SGB; int Mrows; float* SSQ;
    __device__ __forceinline__ bool swapped(const Unit& u) const { return u.pn >= 8 && u.pn < 12; }
    __device__ __forceinline__ void mid(f32x4 (&)[2][2][4][2], const Unit&, int, int, int, int) const {}
    __device__ __forceinline__ void operator()(const f32x4 (&acc)[2][2][4][2], const Unit& u, int wr, int wc, int fr, int fq) const {
        bf16_t* base; int ldc, rbase, cbase, act;
        if (u.pn < 4)       { base = P;   ldc = 1024;  rbase = u.pm * BM;       cbase = u.pn * BM;        act = 0; }
        else if (u.pn < 8)  { base = U;   ldc = 1024;  rbase = u.pm * BM;       cbase = (u.pn - 4) * BM;  act = 1; }
        else if (u.pn < 12) { base = VT;  ldc = Mrows; rbase = (u.pn - 8) * BM; cbase = u.pm * BM;        act = 1; }
        else if (u.pn < 20) { base = SGA; ldc = 2048;  rbase = u.pm * BM;       cbase = (u.pn - 12) * BM; act = 2; }
        else                { base = SGB; ldc = 2048;  rbase = u.pm * BM;       cbase = (u.pn - 20) * BM; act = 2; }
        const int row0 = rbase + wr * 64 + fr, col0 = cbase + wc * 32 + 8 * fq;
        const bool vt = u.pn >= 8 && u.pn < 12;
        f32x4 sq[2][2];
#pragma unroll
        for (int bj = 0; bj < 2; ++bj)
#pragma unroll
            for (int n = 0; n < 2; ++n) sq[bj][n] = (f32x4){0.f, 0.f, 0.f, 0.f};
#pragma unroll
        for (int ai = 0; ai < 2; ++ai)
#pragma unroll
            for (int m = 0; m < 4; ++m) { bf16_t* rowp = base + (size_t)(row0 + ai * HALF + m * 16) * ldc + col0;
#pragma unroll
                for (int bj = 0; bj < 2; ++bj) { f32x4 v0 = acc[ai][bj][m][0], v1 = acc[ai][bj][m][1];
                    if (act == 1) { v0 = gelu_4(v0); v1 = gelu_4(v1);
                        if (vt) { sq[bj][0] += v0 * v0; sq[bj][1] += v1 * v1; } }
                    else if (act == 2) { v0 = sigmoid_4(v0); v1 = sigmoid_4(v1); }
                    *(u32x4*)(rowp + bj * HALF) = pack8(v0, v1); } }
        if (vt) {
#pragma unroll
            for (int bj = 0; bj < 2; ++bj)
#pragma unroll
                for (int n = 0; n < 2; ++n)
#pragma unroll
                    for (int j = 0; j < 4; ++j) sq[bj][n][j] = row16_sum(sq[bj][n][j]);
            if (fr == 0) { float* dst = SSQ + (size_t)((u.pn - 8) * 2 + wr) * Mrows + cbase + wc * 32 + 8 * fq;
#pragma unroll
                for (int bj = 0; bj < 2; ++bj)
#pragma unroll
                    for (int n = 0; n < 2; ++n) *(f32x4*)(dst + bj * HALF + 4 * n) = sq[bj][n]; }
        }
    }
};
struct EpiGate {
    static constexpr bool PERM = true, AFTER_DRAIN = false, SWAP = false, MID = true;
    const bf16_t *SGA, *SGB; bf16_t* O;
    __device__ __forceinline__ bool swapped(const Unit&) const { return false; }
    __device__ __forceinline__ void mid(f32x4 (&acc)[2][2][4][2], const Unit& u, int wr, int wc, int fr, int fq) const {
        const int row0 = u.pm * BM + wr * 64 + fr, col0 = u.pn * BM + wc * 32 + 8 * fq;
#pragma unroll
        for (int ai = 0; ai < 2; ++ai)
#pragma unroll
            for (int m = 0; m < 4; ++m) { const size_t off = (size_t)(row0 + ai * HALF + m * 16) * 2048 + col0;
#pragma unroll
                for (int bj = 0; bj < 2; ++bj) { const u32x4 a = *(const u32x4*)(SGA + off + bj * HALF), b = *(const u32x4*)(SGB + off + bj * HALF);
#pragma unroll
                    for (int k = 0; k < 4; ++k) { const float rl = bf_lo(a[k]) * __builtin_amdgcn_rcpf(fmaxf(bf_lo(b[k]), 1e-30f)), rh = bf_hi(a[k]) * __builtin_amdgcn_rcpf(fmaxf(bf_hi(b[k]), 1e-30f));
                        acc[ai][bj][m][k >> 1][(k & 1) * 2] *= rl; acc[ai][bj][m][k >> 1][(k & 1) * 2 + 1] *= rh; } } }
    }
    __device__ __forceinline__ void operator()(const f32x4 (&acc)[2][2][4][2], const Unit& u, int wr, int wc, int fr, int fq) const {
        const int row0 = u.pm * BM + wr * 64 + fr, col0 = u.pn * BM + wc * 32 + 8 * fq;
#pragma unroll
        for (int ai = 0; ai < 2; ++ai)
#pragma unroll
            for (int m = 0; m < 4; ++m) { const size_t off = (size_t)(row0 + ai * HALF + m * 16) * 2048 + col0;
#pragma unroll
                for (int bj = 0; bj < 2; ++bj) { const u32x4 b = *(const u32x4*)(SGB + off + bj * HALF);
                    const f32x4 s0 = {fmaxf(bf_lo(b[0]), 1e-30f), fmaxf(bf_hi(b[0]), 1e-30f), fmaxf(bf_lo(b[1]), 1e-30f), fmaxf(bf_hi(b[1]), 1e-30f)};
                    const f32x4 s1 = {fmaxf(bf_lo(b[2]), 1e-30f), fmaxf(bf_hi(b[2]), 1e-30f), fmaxf(bf_lo(b[3]), 1e-30f), fmaxf(bf_hi(b[3]), 1e-30f)};
                    *(u32x4*)((char*)O + blk_byte(row0 + ai * HALF + m * 16, col0 + bj * HALF, 2048)) = pack8(acc[ai][bj][m][0] * s0, acc[ai][bj][m][1] * s1); } }
    }
};

template <class Epi, class Sched, bool ALIGN_EPI = false, bool SP2 = false>
__device__ __forceinline__ void gemm_phase(PG8_LAS unsigned char* lds, const Gemm g, const Sched& S, const Epi& E) {
    int tid = threadIdx.x; asm volatile("" : "+v"(tid));
    const int wid = __builtin_amdgcn_readfirstlane(tid >> 6), lane = tid & 63, wr = wid >> 2, wc = wid & 3, fr = lane & 15, fq = lane >> 4;
    const int K = g.K, nt = K / BK;
    unsigned voffA[2], voffB[2];
#pragma unroll
    for (int i = 0; i < 2; ++i) { voffA[i] = (unsigned)(wid * 2048 + lane * 16 + i * 1024); voffB[i] = voffA[i]; }
    const size_t kstep = (size_t)HTB;
    const size_t hstepA = (size_t)g.lda * 256, hstepB = (size_t)g.ldb * 256;
    const size_t tstepA = 2 * hstepA, tstepB = 2 * hstepB;
    const unsigned ldsw = (unsigned)wid * 2048u;
    const int aoff = lds_byte(wr * 64 + fr, fq * 8);
    const int boff0 = lds_byte(wc * 32 + (Epi::PERM ? perm32(fr) : fr), fq * 8), boff1 = lds_byte(wc * 32 + (Epi::PERM ? perm32(16 + fr) : 16 + fr), fq * 8);
#define PG8_SA(b, h) (((b) * 2 + (h)) * HTB)
#define PG8_SB(b, h) ((4 + (b) * 2 + (h)) * HTB)
#define PG8_STAGE(bufoff, gbase, voff) do { const unsigned* _g = (const unsigned*)((const char*)(gbase) + (voff)[0]); PG8_LAS unsigned* _l = (PG8_LAS unsigned*)(lds + (bufoff) + ldsw); \
        __builtin_amdgcn_global_load_lds(_g, _l, 16, 0, 0); __builtin_amdgcn_global_load_lds(_g, _l, 16, 1024, 0); } while (0)
#define PG8_LDA(dst, b, h) do { _Pragma("unroll") for (int m = 0; m < 4; ++m) _Pragma("unroll") for (int k = 0; k < 2; ++k) dst[m][k] = *(const PG8_LAS bf16x8*)(lds + PG8_SA(b, h) + aoff + m * 2048 + k * 1024); } while (0)
#define PG8_LDB(dst, b, h) do { _Pragma("unroll") for (int n = 0; n < 2; ++n) _Pragma("unroll") for (int k = 0; k < 2; ++k) dst[n][k] = *(const PG8_LAS bf16x8*)(lds + PG8_SB(b, h) + (n ? boff1 : boff0) + k * 1024); } while (0)
#define PG8_MMA(ai, bj, At, Bt) do { __builtin_amdgcn_s_setprio(1); _Pragma("unroll") for (int m = 0; m < 4; ++m) _Pragma("unroll") for (int n = 0; n < 2; ++n) _Pragma("unroll") for (int k = 0; k < 2; ++k) \
        acc[ai][bj][m][n] = __builtin_amdgcn_mfma_f32_16x16x32_bf16(Bt[n][k], At[m][k], acc[ai][bj][m][n], 0, 0, 0); __builtin_amdgcn_s_setprio(0); } while (0)
#define PG8_WAIT_V(n) asm volatile("s_waitcnt vmcnt(" #n ")" ::: "memory")
#define PG8_WAIT_L(n) asm volatile("s_waitcnt lgkmcnt(" #n ")" ::: "memory")
#define PG8_BAR __builtin_amdgcn_s_barrier()
#define PG8_SCHED __builtin_amdgcn_sched_barrier(0)
#define PG8_UNIT_PTRS(u, pa, pb) do { const char* _a = (const char*)g.A + (size_t)(u).pm * tstepA + (size_t)(u).pn * (size_t)(g.a_pn_koff >> 6) * HTB; const char* _b = (const char*)g.Bt + (size_t)(u).pn * tstepB; \
        if (Epi::SWAP && E.swapped(u)) { pa = _b; pb = _a; } else { pa = _a; pb = _b; } } while (0)
    Unit cur, nxt; int ui = 0;
    if (!S.next(0, cur)) return;
    f32x4 acc[2][2][4][2];
#pragma unroll
    for (int a = 0; a < 2; ++a)
#pragma unroll
        for (int b = 0; b < 2; ++b)
#pragma unroll
            for (int m = 0; m < 4; ++m)
#pragma unroll
                for (int n = 0; n < 2; ++n) acc[a][b][m][n] = (f32x4){0.f, 0.f, 0.f, 0.f};
    bf16x8 At[4][2], B0[2][2], B1[2][2];
    const char* cA; const char* cB; PG8_UNIT_PTRS(cur, cA, cB);
    S.a_ready(cur);
    if constexpr (SP2) {
        PG8_STAGE(PG8_SB(0, 0), cB, voffB); PG8_STAGE(PG8_SB(0, 1), cB + hstepB, voffB); PG8_STAGE(PG8_SA(0, 0), cA, voffA); PG8_STAGE(PG8_SA(0, 1), cA + hstepA, voffA);
        if (wr == 1) PG8_BAR;
        PG8_WAIT_V(2); PG8_BAR;
        PG8_STAGE(PG8_SB(1, 0), cB + kstep, voffB); PG8_STAGE(PG8_SA(1, 0), cA + kstep, voffA); PG8_STAGE(PG8_SB(1, 1), cB + hstepB + kstep, voffB);
        PG8_WAIT_V(6); PG8_BAR;
    } else {
        PG8_STAGE(PG8_SB(0, 0), cB, voffB); PG8_STAGE(PG8_SA(0, 0), cA, voffA); PG8_STAGE(PG8_SB(0, 1), cB + hstepB, voffB); PG8_STAGE(PG8_SA(0, 1), cA + hstepA, voffA);
        if (wr == 1) PG8_BAR;
        PG8_WAIT_V(4); PG8_BAR;
        PG8_STAGE(PG8_SB(1, 0), cB + kstep, voffB); PG8_STAGE(PG8_SA(1, 0), cA + kstep, voffA); PG8_STAGE(PG8_SB(1, 1), cB + hstepB + kstep, voffB);
        PG8_WAIT_V(6); PG8_BAR;
    }
    for (;;) {
        const bool has_next = S.next(ui + 1, nxt);
        const char* nA = cA; const char* nB = cB; if (has_next) PG8_UNIT_PTRS(nxt, nA, nB);
        for (int t = 0; t < nt; t += 2) {
            const bool last = (t == nt - 2);
            const char* a1 = cA + (size_t)(t + 1) * kstep;
            const char* a2 = last ? nA : cA + (size_t)(t + 2) * kstep; const char* b2 = last ? nB : cB + (size_t)(t + 2) * kstep;
            const char* a3 = a2 + kstep; const char* b3 = b2 + kstep;
            if (last && has_next) S.a_ready(nxt);
            if constexpr (Epi::MID) { if (t == (nt >> 1)) { int tz = threadIdx.x; asm volatile("" : "+v"(tz)); const int w2 = __builtin_amdgcn_readfirstlane(tz >> 6), l2 = tz & 63; E.mid(acc, cur, w2 >> 2, w2 & 3, l2 & 15, l2 >> 4); } }
            if constexpr (SP2) {
            PG8_LDB(B0, 0, 0); PG8_LDB(B1, 0, 1); PG8_SCHED; PG8_LDA(At, 0, 0); PG8_STAGE(PG8_SA(1, 1), a1 + hstepA, voffA);
            PG8_WAIT_V(8); PG8_WAIT_L(0); PG8_BAR; PG8_MMA(0, 0, At, B0); PG8_MMA(0, 1, At, B1); PG8_BAR; PG8_SCHED;
            PG8_LDA(At, 0, 1); PG8_STAGE(PG8_SB(0, 0), b2, voffB); PG8_STAGE(PG8_SB(0, 1), b2 + hstepB, voffB); PG8_STAGE(PG8_SA(0, 0), a2, voffA);
            PG8_WAIT_V(8); PG8_WAIT_L(0); PG8_BAR; PG8_MMA(1, 0, At, B0); PG8_MMA(1, 1, At, B1); PG8_BAR; PG8_SCHED;
            PG8_LDB(B0, 1, 0); PG8_LDB(B1, 1, 1); PG8_SCHED; PG8_LDA(At, 1, 0); PG8_STAGE(PG8_SA(0, 1), a2 + hstepA, voffA);
            PG8_WAIT_V(8); PG8_WAIT_L(0); PG8_BAR; PG8_MMA(0, 0, At, B0); PG8_MMA(0, 1, At, B1); PG8_BAR; PG8_SCHED;
            PG8_LDA(At, 1, 1); PG8_STAGE(PG8_SB(1, 0), b3, voffB); PG8_STAGE(PG8_SB(1, 1), b3 + hstepB, voffB); PG8_STAGE(PG8_SA(1, 0), a3, voffA);
            PG8_WAIT_V(8); PG8_WAIT_L(0); PG8_BAR; PG8_MMA(1, 0, At, B0); PG8_MMA(1, 1, At, B1); PG8_BAR; PG8_SCHED;
            } else {
            PG8_LDB(B0, 0, 0); PG8_SCHED; PG8_LDA(At, 0, 0); PG8_STAGE(PG8_SA(1, 1), a1 + hstepA, voffA);
            PG8_WAIT_L(8); PG8_BAR; PG8_WAIT_L(0); PG8_MMA(0, 0, At, B0); PG8_BAR; PG8_SCHED;
            PG8_LDB(B1, 0, 1); PG8_STAGE(PG8_SB(0, 0), b2, voffB);
            PG8_BAR; PG8_WAIT_L(0); PG8_MMA(0, 1, At, B1); PG8_BAR;
            PG8_LDA(At, 0, 1); PG8_STAGE(PG8_SA(0, 0), a2, voffA);
            PG8_BAR; PG8_WAIT_L(0); PG8_MMA(1, 0, At, B0); PG8_BAR; PG8_SCHED;
            PG8_STAGE(PG8_SB(0, 1), b2 + hstepB, voffB);
            PG8_WAIT_V(6); PG8_BAR; PG8_MMA(1, 1, At, B1); PG8_BAR;
            PG8_LDB(B0, 1, 0); PG8_SCHED; PG8_LDA(At, 1, 0); PG8_STAGE(PG8_SA(0, 1), a2 + hstepA, voffA);
            PG8_WAIT_L(8); PG8_BAR; PG8_WAIT_L(0); PG8_MMA(0, 0, At, B0); PG8_BAR; PG8_SCHED;
            PG8_LDB(B1, 1, 1); PG8_STAGE(PG8_SB(1, 0), b3, voffB);
            PG8_BAR; PG8_WAIT_L(0); PG8_MMA(0, 1, At, B1); PG8_BAR;
            PG8_LDA(At, 1, 1); PG8_STAGE(PG8_SA(1, 0), a3, voffA);
            PG8_BAR; PG8_WAIT_L(0); PG8_MMA(1, 0, At, B0); PG8_BAR; PG8_SCHED;
            PG8_STAGE(PG8_SB(1, 1), b3 + hstepB, voffB);
            PG8_WAIT_V(6); PG8_BAR; PG8_MMA(1, 1, At, B1); PG8_BAR;
            }
        }
        if constexpr (ALIGN_EPI) { if (wr == 0) PG8_BAR; }
        { int tz = threadIdx.x; asm volatile("" : "+v"(tz)); const int w2 = __builtin_amdgcn_readfirstlane(tz >> 6), l2 = tz & 63; E(acc, cur, w2 >> 2, w2 & 3, l2 & 15, l2 >> 4); }
        S.done(cur);
        if (!has_next) break;
#pragma unroll
        for (int a = 0; a < 2; ++a)
#pragma unroll
            for (int b = 0; b < 2; ++b)
#pragma unroll
                for (int m = 0; m < 4; ++m)
#pragma unroll
                    for (int n = 0; n < 2; ++n) acc[a][b][m][n] = (f32x4){0.f, 0.f, 0.f, 0.f};
        cur = nxt; cA = nA; cB = nB; ++ui;
        if constexpr (ALIGN_EPI) { if (wr == 1) PG8_BAR; }
    }
    PG8_WAIT_V(0);
    if constexpr (!ALIGN_EPI) { if (wr == 0) PG8_BAR; }
    PG8_BAR;
#undef PG8_SA
#undef PG8_SB
#undef PG8_STAGE
#undef PG8_LDA
#undef PG8_LDB
#undef PG8_MMA
#undef PG8_WAIT_V
#undef PG8_WAIT_L
#undef PG8_BAR
#undef PG8_SCHED
#undef PG8_UNIT_PTRS
}
}

constexpr int NWAVES = 8;
constexpr int BATCH = 4, SEQ = 4096, D = 2048, FF = 5632, NUP = 2 * FF, NIN = 7168, PW = 1024, SW = 1024, NL = 4;
constexpr int M = BATCH * SEQ;
constexpr float EPS = 1e-6f;
constexpr int N_PHASES = 2 + 11 * NL;

constexpr size_t MiB = 1u << 20;
constexpr size_t WS_CTL = 0, CTL_ZERO_BYTES = 1 * MiB;
constexpr size_t WS_W = 2 * MiB;
constexpr size_t LW_UP1 = 0, LW_DN1 = 44 * MiB, LW_WIN = 66 * MiB, LW_WG = 94 * MiB, LW_WPS = 94 * MiB + MiB / 2, LW_WO = 102 * MiB + MiB / 2, LW_UP2 = 110 * MiB + MiB / 2, LW_DN2 = 154 * MiB + MiB / 2;
constexpr size_t LW_STRIDE = 176 * MiB + MiB / 2;
static_assert((size_t)NUP * D * 2 == 44 * MiB && (size_t)D * FF * 2 == 22 * MiB && (size_t)NIN * D * 2 == 28 * MiB && (size_t)1024 * 256 * 2 == MiB / 2 && (size_t)D * D * 2 == 8 * MiB, "weight sizes");
constexpr size_t WS_H = WS_W + NL * LW_STRIDE;
constexpr size_t WS_F = WS_H + 64 * MiB;
constexpr size_t WS_R = WS_F + 64 * MiB;
constexpr size_t WS_P = WS_R, WS_U = WS_R + 32 * MiB, WS_VT = WS_R + 64 * MiB, WS_P1 = WS_R + 96 * MiB, WS_SGA = WS_R + 128 * MiB, WS_SGB = WS_R + 192 * MiB, WS_YZ = WS_R + 256 * MiB, WS_MM = WS_R + 320 * MiB;
constexpr size_t WS_ACT = WS_R + 384 * MiB;
constexpr size_t WS_SSQ = WS_ACT + 176 * MiB;
constexpr size_t WS_XB = WS_SSQ + 1 * MiB;
constexpr size_t WS_END = WS_XB + 64 * MiB;
constexpr size_t WS_TPO = WS_R, WS_TGS = WS_R + 16 * MiB;
static_assert((size_t)M * FF * 2 == 176 * MiB && WS_H == 708 * MiB, "ws map");
constexpr int CW_BAR = 4096, CW_QUAD = 8192;

constexpr int RING_OFF = 0, RING_BYTES = 131072;
constexpr int LDSCTL_OFF = RING_BYTES, MISC_OFF = LDSCTL_OFF + 320;
constexpr int LDS_BYTES = 147456;
static_assert(MISC_OFF + 128 <= LDS_BYTES, "LDS map");

#define GAS __attribute__((address_space(1)))
#define LAS __attribute__((address_space(3)))
typedef unsigned short bf16;
typedef unsigned v4u __attribute__((ext_vector_type(4)));
typedef unsigned v2u __attribute__((ext_vector_type(2)));
typedef float f32x4 __attribute__((ext_vector_type(4)));
typedef short bf16x8 __attribute__((ext_vector_type(8)));
typedef GAS unsigned gu32;
#define RLX_AGENT __ATOMIC_RELAXED, __HIP_MEMORY_SCOPE_AGENT
#define LDS_WAIT() asm volatile("s_waitcnt lgkmcnt(0)" ::: "memory")
#define VM_WAIT() asm volatile("s_waitcnt vmcnt(0)" ::: "memory")
__device__ __forceinline__ unsigned f2bf(float f) { unsigned u = __builtin_bit_cast(unsigned, f); return (u + 0x7fffu + ((u >> 16) & 1u)) >> 16; }
__device__ __forceinline__ unsigned pk2(float lo, float hi) { return pg8::cvt_pk_bf16(lo, hi); }
__device__ __forceinline__ float bflo(unsigned w) { return __uint_as_float(w << 16); }
__device__ __forceinline__ float bfhi(unsigned w) { return __uint_as_float(w & 0xffff0000u); }

#define XB_TMO      128
#define XB_XCNT(j)  (256  + 64 * (j))
#define XB_XSUB(j)  (1280 + 64 * (j))
#define XB_XGEN(j)  (2304 + 64 * (j))
#define XB_TOP      3328
#define XB_TOPGEN   3392
#define XCD_BAR_WORDS 3456
#define XB_PTOP(p)    (3456 + 128 * (p))
#define XB_PTOPGEN(p) (3520 + 128 * (p))
#define XB_SPIN_CAP (1u << 18)

__device__ __forceinline__ unsigned xb_ld(unsigned* p)              { return __hip_atomic_load(p, __ATOMIC_RELAXED, __HIP_MEMORY_SCOPE_AGENT); }
__device__ __forceinline__ unsigned xb_add(unsigned* p, unsigned v) { return __hip_atomic_fetch_add(p, v, __ATOMIC_RELAXED, __HIP_MEMORY_SCOPE_AGENT); }
__device__ __forceinline__ unsigned xb_xcc_id() { return (unsigned)__builtin_amdgcn_s_getreg((3 << 11) | 20) & 0xFu; }
#define XB_SPIN(cond, bar) do { unsigned _sp = 0; while (cond) { __builtin_amdgcn_s_sleep(1); \
    if ((++_sp & 255u) == 0u) { if (xb_ld(&(bar)[XB_TMO])) break; if (_sp > XB_SPIN_CAP) { atomicAdd(&(bar)[XB_TMO], 1u); break; } } } } while (0)

struct XcdBarrier {
    unsigned* bar; unsigned x;
    volatile LAS unsigned* st;
};
__device__ __forceinline__ XcdBarrier xcd_barrier_post(unsigned* bar, volatile LAS unsigned* st) {
    XcdBarrier b; b.bar = bar; b.x = xb_xcc_id(); b.st = st;
    if (threadIdx.x == 0) st[2] = xb_add(&bar[XB_XCNT(b.x)], 1u);
    return b;
}
__device__ __forceinline__ void xcd_barrier_complete(unsigned* bar, unsigned x, unsigned& nloc, unsigned& nx, unsigned& uni) {
    const unsigned G = gridDim.x * gridDim.y * gridDim.z;
    unsigned sum, cnt, mine, sp = 0u;
    for (;;) {
        sum = 0u; cnt = 0u; mine = 0u; uni = 1u;
#pragma unroll
        for (unsigned j = 0; j < 16; ++j) { const unsigned c = xb_ld(&bar[XB_XCNT(j)]); sum += c; cnt += (c > 0u) ? 1u : 0u; mine = (j == x) ? c : mine; if (c != (j < 8u ? 32u : 0u)) uni = 0u; }
        if (sum == G) break;
        __builtin_amdgcn_s_sleep(1);
        if ((++sp & 255u) == 0u) { if (xb_ld(&bar[XB_TMO])) break; if (sp > XB_SPIN_CAP) { atomicAdd(&bar[XB_TMO], 1u); break; } }
    }
    nloc = mine > 0u ? mine : 1u; nx = cnt > 0u ? cnt : 1u; if (sum != G) uni = 0u;
}
__device__ __forceinline__ void xcd_barrier(const XcdBarrier& b, const bool pair) {
    asm volatile("s_waitcnt vmcnt(0)" ::: "memory");
    __syncthreads();
    if (threadIdx.x == 0) {
        unsigned* bar = b.bar;
        __builtin_amdgcn_s_waitcnt(0);
        unsigned nloc = b.st[0], nx = b.st[1];
        if (nloc == 0u) { unsigned uni; xcd_barrier_complete(bar, b.x, nloc, nx, uni); b.st[0] = nloc; b.st[1] = nx; b.st[3] = uni; }
        const unsigned old = xb_add(&bar[XB_XSUB(b.x)], 1u);
        const unsigned gen = old / nloc;
        if (old + 1u == (gen + 1u) * nloc) {
            __builtin_amdgcn_fence(__ATOMIC_RELEASE, "agent");
            asm volatile("s_waitcnt vmcnt(0)" ::: "memory");
            if (!pair) {
            const unsigned og = xb_add(&bar[XB_TOP], 1u);
            const unsigned tg = og / nx;
            if (og + 1u == (tg + 1u) * nx) xb_add(&bar[XB_TOPGEN], 1u);
            else XB_SPIN(xb_ld(&bar[XB_TOPGEN]) == tg, bar);
            } else {
            unsigned* top = &bar[XB_PTOP(b.x >> 1)]; unsigned* tgen = &bar[XB_PTOPGEN(b.x >> 1)];
            const unsigned og = xb_add(top, 1u);
            const unsigned tg = og / 2u;
            if (og + 1u == (tg + 1u) * 2u) xb_add(tgen, 1u);
            else XB_SPIN(xb_ld(tgen) == tg, bar);
            }
            __builtin_amdgcn_fence(__ATOMIC_ACQUIRE, "agent");
            xb_add(&bar[XB_XGEN(b.x)], 1u);
            asm volatile("s_waitcnt vmcnt(0)" ::: "memory");
        } else {
            XB_SPIN(xb_ld(&bar[XB_XGEN(b.x)]) == gen, bar);
            __builtin_amdgcn_fence(__ATOMIC_ACQUIRE, "agent");
            asm volatile("s_waitcnt vmcnt(0)" ::: "memory");
        }
    }
    __syncthreads();
}

__device__ __forceinline__ void quad_barrier(unsigned* cnt, unsigned* tmo) {
    asm volatile("s_waitcnt vmcnt(0)" ::: "memory");
    __syncthreads();
    if (threadIdx.x == 0) {
        __builtin_amdgcn_s_waitcnt(0);
        const unsigned old = xb_add(cnt, 1u), target = (old / 4u + 1u) * 4u;
        unsigned sp = 0;
        while (xb_ld(cnt) < target) { __builtin_amdgcn_s_sleep(1); if ((++sp & 255u) == 0u) { if (xb_ld(tmo)) break; if (sp > XB_SPIN_CAP) { atomicAdd(tmo, 1u); break; } } }
        __builtin_amdgcn_fence(__ATOMIC_ACQUIRE, "agent");
        asm volatile("s_waitcnt vmcnt(0)" ::: "memory");
    }
    __syncthreads();
}

struct Frame {
    LAS unsigned char* lds;
    volatile LAS unsigned* MISC;
    gu32* ctl;
    int vcu, G;
    int gx, gr, grp;
};
struct Lane { int tid, lane, wave; };
__device__ __forceinline__ Lane opaque_lane() { int t = threadIdx.x; asm volatile("" : "+v"(t)); Lane q; q.tid = t; q.lane = t & 63; q.wave = __builtin_amdgcn_readfirstlane(t >> 6); return q; }
__device__ __forceinline__ float wave_sum(float v) {
    v = pg8::row16_sum(v);
    const float r0 = __builtin_bit_cast(float, __builtin_amdgcn_readlane(__builtin_bit_cast(int, v), 0)), r1 = __builtin_bit_cast(float, __builtin_amdgcn_readlane(__builtin_bit_cast(int, v), 16));
    const float r2 = __builtin_bit_cast(float, __builtin_amdgcn_readlane(__builtin_bit_cast(int, v), 32)), r3 = __builtin_bit_cast(float, __builtin_amdgcn_readlane(__builtin_bit_cast(int, v), 48));
    return (r0 + r1) + (r2 + r3);
}

__device__ __forceinline__ void p0_transpose_item(const float* __restrict__ W, int Ns, bf16* __restrict__ WT, int dld, int koff, int mode, LAS float* scr, int item, int lane) {
    const int nblk = Ns / 64, kb = item / nblk, nb = item % nblk, k0 = 64 * kb, n0 = 64 * nb;
    const int n0s = mode ? (((n0 >> 7) & 1) * FF + (n0 >> 8) * 128 + (n0 & 127)) : n0;
    const __amdgpu_buffer_rsrc_t rs = __builtin_amdgcn_make_buffer_rsrc((void*)W, 0, 0x7fffffff, 0x00020000);
    const int voff = (int)(((size_t)k0 * Ns + n0s + lane) * 4), rowb = Ns * 4;
    float wv[64];
#pragma unroll
    for (int k = 0; k < 64; ++k) wv[k] = __builtin_bit_cast(float, __builtin_amdgcn_raw_buffer_load_b32(rs, voff, k * rowb, W_AUX));
    LAS unsigned* scu = (LAS unsigned*)scr;
#pragma unroll
    for (int i = 0; i < 32; ++i) scu[i * 64 + (lane ^ (((i >> 2) & 3) << 3))] = pk2(wv[2 * i], wv[2 * i + 1]);
    LDS_WAIT(); asm volatile("" ::: "memory");
    const int rr = lane >> 2, ch = lane & 3;
#pragma unroll
    for (int j = 0; j < 8; ++j) { const int n = 16 * (j >> 1) + rr, kk = (j & 1) * 32 + 8 * ch; const LAS unsigned* sp = scu + (kk >> 1) * 64 + (n ^ (8 * ch));
        v4u o; o.x = sp[0 * 64]; o.y = sp[1 * 64]; o.z = sp[2 * 64]; o.w = sp[3 * 64];
        *(v4u*)((char*)WT + pg8::blk_byte(n0 + n, koff + k0 + kk, dld)) = o; }
    LDS_WAIT(); asm volatile("" ::: "memory");
}

struct Args { const float* in[20]; float* out; unsigned char* ws; int ph_lo, ph_hi; };

template <int MODE>
__device__ __forceinline__ void p0_items(Frame& F, const Args& args, int lsel) {
    const Lane T = opaque_lane();
    LAS float* scr = (LAS float*)(F.lds + RING_OFF + T.wave * 16384);
    const int gw = F.vcu * NWAVES + T.wave, NGW = F.G * NWAVES;
    constexpr int I_UP = (D / 64) * (NUP / 64), I_DN = (FF / 64) * (D / 64), I_IN = (D / 64) * (NIN / 64), I_G = 4 * 256 * 256 / 2048, I_WS = 8 * 128 * 128 / 2048, I_PO = (PW / 64) * (D / 64), I_SO = I_PO, I_O = (D / 64) * (D / 64);
    constexpr int PER_LAYER = 2 * I_UP + 2 * I_DN + I_IN + I_G + I_WS + I_PO + I_SO + I_O;
    constexpr int OFF_G = I_UP + I_DN + I_IN, OFF_PO = OFF_G + I_G + I_WS, I_SMALL = I_G + I_PO;
    constexpr int NITEMS = MODE == 0 ? PER_LAYER + (NL - 1) * I_SMALL : PER_LAYER - I_SMALL;
    for (int it = gw; it < NITEMS; it += NGW) {
        int l, r;
        if constexpr (MODE == 0) { if (it < PER_LAYER) { l = 0; r = it; } else { const int j = it - PER_LAYER, q = j % I_SMALL; l = 1 + j / I_SMALL; r = q < I_G ? OFF_G + q : OFF_PO + (q - I_G); } }
        else { l = lsel; r = it; if (r >= OFF_G) r += I_G; if (r >= OFF_PO) r += I_PO; }
        unsigned char* wl = args.ws + WS_W + (size_t)l * LW_STRIDE;
        if (r < I_UP) { p0_transpose_item(args.in[2] + (size_t)l * D * NUP, NUP, (bf16*)(wl + LW_UP1), D, 0, 1, scr, r, T.lane); continue; } r -= I_UP;
        if (r < I_DN) { p0_transpose_item(args.in[3] + (size_t)l * FF * D, D, (bf16*)(wl + LW_DN1), FF, 0, 0, scr, r, T.lane); continue; } r -= I_DN;
        if (r < I_IN) { p0_transpose_item(args.in[6] + (size_t)l * D * NIN, NIN, (bf16*)(wl + LW_WIN), D, 0, 0, scr, r, T.lane); continue; } r -= I_IN;
        if (r < I_G)  {
                        const float* src = args.in[7] + (size_t)l * 262144 + (size_t)r * 2048; const float* sc = args.in[8] + (size_t)l * PW + (r >> 5) * 256 + 4 * T.lane;
                        const f32x4 sv = *(const f32x4*)sc;
#pragma unroll
                        for (int p = 0; p < 8; ++p) { const f32x4 v = *(const f32x4*)(src + p * 256 + 4 * T.lane) * sv; v2u o; o.x = pk2(v.x, v.y); o.y = pk2(v.z, v.w);
                            *(v2u*)((char*)(args.ws + WS_TGS + (size_t)l * (MiB / 2)) + pg8::blk_byte(8 * r + p, 4 * T.lane, 256)) = o; }
                        continue; } r -= I_G;
        if (r < I_WS) {
                        const float* src = args.in[11] + (size_t)l * 131072 + (size_t)r * 2048; bf16* dst = (bf16*)(wl + LW_WG) + (size_t)r * 2048;
#pragma unroll
                        for (int p = 0; p < 8; ++p) { const int t = (16 * r + 2 * p + (T.lane >> 5)) & 127, s0 = (4 * T.lane) & 127; const f32x4 v = *(const f32x4*)(src + p * 256 + 4 * T.lane);
                            v2u o; o.x = pk2(s0 <= t ? v.x : 0.f, s0 + 1 <= t ? v.y : 0.f); o.y = pk2(s0 + 2 <= t ? v.z : 0.f, s0 + 3 <= t ? v.w : 0.f); *(v2u*)(dst + p * 256 + 4 * T.lane) = o; }
                        continue; } r -= I_WS;
        if (r < I_PO) { p0_transpose_item(args.in[9] + (size_t)l * PW * D, D, (bf16*)(args.ws + WS_TPO + (size_t)l * 4 * MiB), 1024, 0, 0, scr, r, T.lane); continue; } r -= I_PO;
        if (r < I_SO) { p0_transpose_item(args.in[13] + (size_t)l * SW * D, D, (bf16*)(wl + LW_WPS), 2048, 1024, 0, scr, r, T.lane); continue; } r -= I_SO;
        if (r < I_O)  { p0_transpose_item(args.in[14] + (size_t)l * D * D, D, (bf16*)(wl + LW_WO), D, 0, 0, scr, r, T.lane); continue; } r -= I_O;
        if (r < I_UP) { p0_transpose_item(args.in[17] + (size_t)l * D * NUP, NUP, (bf16*)(wl + LW_UP2), D, 0, 1, scr, r, T.lane); continue; } r -= I_UP;
        p0_transpose_item(args.in[18] + (size_t)l * FF * D, D, (bf16*)(wl + LW_DN2), FF, 0, 0, scr, r, T.lane);
    }
    __syncthreads();
}

typedef _Float16 h16x2 __attribute__((ext_vector_type(2)));
typedef float f32x2_t __attribute__((ext_vector_type(2)));
__device__ __forceinline__ unsigned pk_h2(float a, float b) { const h16x2 h = __builtin_convertvector((f32x2_t){a, b}, h16x2); return __builtin_bit_cast(unsigned, h); }
__device__ __forceinline__ f32x2_t un_h2(unsigned w) { return __builtin_convertvector(__builtin_bit_cast(h16x2, w), f32x2_t); }
template <bool XIN_BF, bool XOUT_BF>
__device__ __forceinline__ void norm_phase(Frame& F, const void* xin_, void* xout_, const bf16* Fb, const float* gpost, float wgt, const float* gnext, bf16* H) {
    const float* xin = (const float*)xin_; float* xout = (float*)xout_; const bf16* xinb = (const bf16*)xin_; bf16* xoutb = (bf16*)xout_;
    const Lane T = opaque_lane();
    const int gw = F.vcu * NWAVES + T.wave, NGW = F.G * NWAVES, lw = 256 * (F.gr & 7) + 64 * (F.gr >> 3) + T.wave;
#define NORM_ROW(i) (F.grp ? (2048 * F.gx + lw + 8 * (i)) : (gw + NGW * (i)))
    const int nrows = F.grp ? 8 : (M - gw + NGW - 1) / NGW;
    f32x4 gp[8], gn[8];
#pragma unroll
    for (int j = 0; j < 8; ++j) { gp[j] = Fb ? ((const f32x4*)gpost)[64 * j + T.lane] : (f32x4){0.f, 0.f, 0.f, 0.f}; gn[j] = gnext ? ((const f32x4*)gnext)[64 * j + T.lane] : (f32x4){0.f, 0.f, 0.f, 0.f}; }
    f32x4 x[8], xn[8]; v2u fw[8], fn[8], xbn[8];
    { const int m = NORM_ROW(0);
      if constexpr (XIN_BF) { const v2u* xr = (const v2u*)(xinb + (size_t)m * D) + T.lane;
#pragma unroll
          for (int j = 0; j < 8; ++j) xbn[j] = __builtin_nontemporal_load(xr + 64 * j); }
      else { const f32x4* xr = (const f32x4*)(xin + (size_t)m * D) + T.lane;
#pragma unroll
          for (int j = 0; j < 8; ++j) xn[j] = __builtin_nontemporal_load(xr + 64 * j); }
      if (Fb) { const v2u* fr = (const v2u*)(Fb + (size_t)m * D) + T.lane;
#pragma unroll
          for (int j = 0; j < 8; ++j) fn[j] = __builtin_nontemporal_load(fr + 64 * j); } }
    for (int i = 0; i < nrows; ++i) {
        const int m = NORM_ROW(i);
#pragma unroll
        for (int j = 0; j < 8; ++j) { if constexpr (XIN_BF) { const v2u w = xbn[j]; const f32x2_t a = un_h2(w.x), b = un_h2(w.y); x[j] = (f32x4){a.x, a.y, b.x, b.y}; } else x[j] = xn[j]; fw[j] = fn[j]; }
        if (i + 1 < nrows) { const int m2 = NORM_ROW(i + 1);
            if constexpr (XIN_BF) { const v2u* xr = (const v2u*)(xinb + (size_t)m2 * D) + T.lane;
#pragma unroll
                for (int j = 0; j < 8; ++j) xbn[j] = __builtin_nontemporal_load(xr + 64 * j); }
            else { const f32x4* xr = (const f32x4*)(xin + (size_t)m2 * D) + T.lane;
#pragma unroll
                for (int j = 0; j < 8; ++j) xn[j] = __builtin_nontemporal_load(xr + 64 * j); }
            if (Fb) { const v2u* fr = (const v2u*)(Fb + (size_t)m2 * D) + T.lane;
#pragma unroll
                for (int j = 0; j < 8; ++j) fn[j] = __builtin_nontemporal_load(fr + 64 * j); } }
        if (Fb) {
            f32x4 f[8]; float ss = 0.f;
#pragma unroll
            for (int j = 0; j < 8; ++j) { const v2u w = fw[j]; f[j] = (f32x4){bflo(w.x), bfhi(w.x), bflo(w.y), bfhi(w.y)}; ss += (f[j].x * f[j].x + f[j].y * f[j].y) + (f[j].z * f[j].z + f[j].w * f[j].w); }
            const float rs = wgt * __builtin_amdgcn_rsqf(wave_sum(ss) * (1.f / D) + EPS);
            if constexpr (XOUT_BF) { v2u* xo = (v2u*)(xoutb + (size_t)m * D) + T.lane;
#pragma unroll
                for (int j = 0; j < 8; ++j) { x[j] = x[j] + (f[j] * rs) * gp[j]; v2u w; w.x = pk_h2(x[j].x, x[j].y); w.y = pk_h2(x[j].z, x[j].w); __builtin_nontemporal_store(w, xo + 64 * j); } }
            else { f32x4* xo = (f32x4*)(xout + (size_t)m * D) + T.lane;
#pragma unroll
                for (int j = 0; j < 8; ++j) { x[j] = x[j] + (f[j] * rs) * gp[j]; __builtin_nontemporal_store(x[j], xo + 64 * j); } }
        }
        if (gnext) {
            float s2 = 0.f;
#pragma unroll
            for (int j = 0; j < 8; ++j) s2 += (x[j].x * x[j].x + x[j].y * x[j].y) + (x[j].z * x[j].z + x[j].w * x[j].w);
            const float rx = __builtin_amdgcn_rsqf(wave_sum(s2) * (1.f / D) + EPS);
#pragma unroll
            for (int j = 0; j < 8; ++j) { const f32x4 v = (x[j] * rx) * gn[j]; v2u w; w.x = pg8::cvt_pk_bf16(v.x, v.y); w.y = pg8::cvt_pk_bf16(v.z, v.w);
                *(v2u*)((char*)H + pg8::blk_byte(m, 256 * j + 4 * T.lane, D)) = w; }
        }
    }
#undef NORM_ROW
}

template <int W> __device__ __forceinline__ void pool_body(const bf16* __restrict__ P, bf16* __restrict__ DP, int ms, int c0) {
    const int tl0 = ms & (SEQ - 1);
    v4u row[W - 1 + 16];
#pragma unroll
    for (int k = 0; k < W - 1; ++k) { const int j = W - 1 - k; row[k] = (tl0 - j >= 0) ? __builtin_nontemporal_load((const v4u*)(P + (size_t)(ms - j) * PW + c0)) : (v4u){0u, 0u, 0u, 0u}; }
#pragma unroll
    for (int i = 0; i < 16; ++i) row[W - 1 + i] = __builtin_nontemporal_load((const v4u*)(P + (size_t)(ms + i) * PW + c0));
    float S[8];
#pragma unroll
    for (int k = 0; k < 8; ++k) S[k] = 0.f;
#pragma unroll
    for (int k = 0; k < W - 1; ++k)
#pragma unroll
        for (int q = 0; q < 4; ++q) { S[2 * q] += bflo(row[k][q]); S[2 * q + 1] += bfhi(row[k][q]); }
#pragma unroll
    for (int i = 0; i < 16; ++i) {
        float cur[8], d[8];
#pragma unroll
        for (int q = 0; q < 4; ++q) { cur[2 * q] = bflo(row[W - 1 + i][q]); cur[2 * q + 1] = bfhi(row[W - 1 + i][q]); }
        const int cnt = (tl0 + i + 1) < W ? (tl0 + i + 1) : W; const float inv = 1.0f / (float)cnt;
#pragma unroll
        for (int k = 0; k < 8; ++k) { S[k] += cur[k]; d[k] = S[k] * inv - cur[k]; }
        v4u o; o.x = pg8::cvt_pk_bf16(d[0], d[1]); o.y = pg8::cvt_pk_bf16(d[2], d[3]); o.z = pg8::cvt_pk_bf16(d[4], d[5]); o.w = pg8::cvt_pk_bf16(d[6], d[7]);
        *(v4u*)((char*)DP + pg8::blk_byte(ms + i, c0, 2048)) = o;
#pragma unroll
        for (int q = 0; q < 4; ++q) { S[2 * q] -= bflo(row[i][q]); S[2 * q + 1] -= bfhi(row[i][q]); }
    }
}
__device__ __forceinline__ void pool_unit(Frame& F, const bf16* __restrict__ P, bf16* __restrict__ DP, int unit) {
    const Lane T = opaque_lane();
    const int g = T.wave & 3, tq = 2 * (T.wave >> 2) + (T.lane >> 5), c0 = g * 256 + (T.lane & 31) * 8, ms = unit * 64 + tq * 16;
    if (g == 0) pool_body<2>(P, DP, ms, c0); else if (g == 1) pool_body<4>(P, DP, ms, c0); else if (g == 2) pool_body<8>(P, DP, ms, c0); else pool_body<16>(P, DP, ms, c0);
}

__device__ __forceinline__ void sgu_unit(Frame& F, const bf16* __restrict__ VT, const bf16* __restrict__ U, bf16* __restrict__ YZ, const float* __restrict__ SSQ, const bf16* __restrict__ WSB,
                                         const float* __restrict__ bs, const float* __restrict__ gain, int unit) {
    const Lane T = opaque_lane();
    const int hg = unit & 1, cn = unit >> 1, m0 = cn * 128;
    LAS float* rstd = (LAS float*)(F.lds + RING_OFF);
    if (T.tid < 128) { float sm = 0.f;
#pragma unroll
        for (int k = 0; k < 8; ++k) sm += SSQ[(size_t)k * M + m0 + T.tid];
        rstd[T.tid] = __builtin_amdgcn_rsqf(sm * (1.f / SW) + EPS); }
    __syncthreads();
    const int fr = T.lane & 15, fq = T.lane >> 4;
    float rs[4][8];
#pragma unroll
    for (int ks = 0; ks < 4; ++ks) { const f32x4 a = *(const LAS f32x4*)(rstd + ks * 32 + 8 * fq), b = *(const LAS f32x4*)(rstd + ks * 32 + 8 * fq + 4);
#pragma unroll
        for (int i = 0; i < 4; ++i) { rs[ks][i] = a[i]; rs[ks][4 + i] = b[i]; } }
    __syncthreads();
    const int h = hg * 4 + (T.wave >> 1);
    const bf16* Wh = WSB + (size_t)h * 16384;
    float bias[8];
#pragma unroll
    for (int jt = 0; jt < 8; ++jt) bias[jt] = bs[h * 128 + 16 * jt + fr];
#pragma unroll
    for (int pr = 0; pr < 2; ++pr) {
        const int cb = h * 128 + (T.wave & 1) * 64 + pr * 32, chA = cb + 8 * (fr >> 2) + (fr & 3);
        bf16x8 xa[4], xb[4];
#pragma unroll
        for (int ks = 0; ks < 4; ++ks) { const v4u qa = __builtin_nontemporal_load((const v4u*)(VT + (size_t)chA * M + m0 + ks * 32 + 8 * fq)), qb = __builtin_nontemporal_load((const v4u*)(VT + (size_t)(chA + 4) * M + m0 + ks * 32 + 8 * fq));
            v4u oa, ob;
#pragma unroll
            for (int k = 0; k < 4; ++k) { oa[k] = pg8::cvt_pk_bf16(bflo(qa[k]) * rs[ks][2 * k], bfhi(qa[k]) * rs[ks][2 * k + 1]); ob[k] = pg8::cvt_pk_bf16(bflo(qb[k]) * rs[ks][2 * k], bfhi(qb[k]) * rs[ks][2 * k + 1]); }
            xa[ks] = __builtin_bit_cast(bf16x8, oa); xb[ks] = __builtin_bit_cast(bf16x8, ob); }
        f32x4 accA[8], accB[8];
#pragma unroll
        for (int jt = 0; jt < 8; ++jt) { accA[jt] = (f32x4){0.f, 0.f, 0.f, 0.f}; accB[jt] = (f32x4){0.f, 0.f, 0.f, 0.f};
#pragma unroll
            for (int ks = 0; ks < 4; ++ks) if (32 * ks <= 16 * jt + 15) { const bf16x8 yf = *(const bf16x8*)(Wh + (16 * jt + fr) * 128 + ks * 32 + 8 * fq);
                accA[jt] = __builtin_amdgcn_mfma_f32_16x16x32_bf16(xa[ks], yf, accA[jt], 0, 0, 0); accB[jt] = __builtin_amdgcn_mfma_f32_16x16x32_bf16(xb[ks], yf, accB[jt], 0, 0, 0); } }
        const int c8 = cb + 8 * fq; const f32x4 ga = *(const f32x4*)(gain + c8), gb = *(const f32x4*)(gain + c8 + 4);
#pragma unroll
        for (int jt = 0; jt < 8; ++jt) { const size_t m = (size_t)(m0 + 16 * jt + fr); const v4u uu = __builtin_nontemporal_load((const v4u*)(U + m * SW + c8)); const float b = bias[jt];
            v4u o;
            o.x = pg8::cvt_pk_bf16(bflo(uu.x) * (accA[jt][0] * ga[0] + b), bfhi(uu.x) * (accA[jt][1] * ga[1] + b)); o.y = pg8::cvt_pk_bf16(bflo(uu.y) * (accA[jt][2] * ga[2] + b), bfhi(uu.y) * (accA[jt][3] * ga[3] + b));
            o.z = pg8::cvt_pk_bf16(bflo(uu.z) * (accB[jt][0] * gb[0] + b), bfhi(uu.z) * (accB[jt][1] * gb[1] + b)); o.w = pg8::cvt_pk_bf16(bflo(uu.w) * (accB[jt][2] * gb[2] + b), bfhi(uu.w) * (accB[jt][3] * gb[3] + b));
            *(v4u*)((char*)YZ + pg8::blk_byte((int)m, 1024 + c8, 2048)) = o; }
    }
}

#ifndef PG8_SP2
#define PG8_SP2 true
#endif
#ifndef PG8_ALIGN
#define PG8_ALIGN true
#endif

__global__ void __launch_bounds__(NWAVES * 64, 2) mk_fwd(Args args) {
    extern __shared__ __attribute__((aligned(16))) unsigned char lds[];
    Frame F;
    F.lds = (LAS unsigned char*)lds;
    F.MISC = (volatile LAS unsigned*)(F.lds + MISC_OFF);
    F.G = gridDim.x; { const int bx = blockIdx.x; F.vcu = (F.G % 8 == 0) ? (bx % 8) * (F.G / 8) + bx / 8 : bx; }
    unsigned char* ws = args.ws;
    F.ctl = (gu32*)(ws + WS_CTL);
    for (int u = threadIdx.x; u < (LDS_BYTES - LDSCTL_OFF) / 4; u += NWAVES * 64) ((LAS unsigned*)(F.lds + LDSCTL_OFF))[u] = 0u;
    __syncthreads();
    const int lo = args.ph_lo, hi = args.ph_hi;
    XcdBarrier bar; bar.bar = (unsigned*)(F.ctl + CW_BAR); bar.x = 0; bar.st = nullptr;
    if (hi - lo > 1) bar = xcd_barrier_post((unsigned*)(F.ctl + CW_BAR), F.MISC + 8);
#define IN(k) (lo <= (k) && (k) < hi)
#define SEAM_G(k) do { if (IN(k) && IN((k) + 1)) xcd_barrier(bar, false); } while (0)
#define SEAM_P(k) do { if (IN(k) && IN((k) + 1)) xcd_barrier(bar, lmode); } while (0)
#define SEAM_L(k) do { if (IN(k) && IN((k) + 1)) { if (lmode) quad_barrier(qcnt, (unsigned*)(F.ctl + CW_BAR) + XB_TMO); else xcd_barrier(bar, false); } } while (0)
    unsigned* qcnt = (unsigned*)(F.ctl + CW_QUAD);
    F.gx = (int)blockIdx.x & 7; F.gr = (int)blockIdx.x >> 3; F.grp = 0;
    bool lmode = false; int cid = (int)blockIdx.x;

    bf16* const Hb = (bf16*)(ws + WS_H); bf16* const Fb = (bf16*)(ws + WS_F); bf16* const ACT = (bf16*)(ws + WS_ACT);
    bf16* const XB = (bf16*)(ws + WS_XB);
    bf16* const Ub = (bf16*)(ws + WS_U); bf16* const VT = (bf16*)(ws + WS_VT);
    bf16* const SGA = (bf16*)(ws + WS_SGA); bf16* const SGB = (bf16*)(ws + WS_SGB); bf16* const YZ = (bf16*)(ws + WS_YZ); bf16* const MM = (bf16*)(ws + WS_MM);

    if (IN(0)) { p0_items<0>(F, args, 0); norm_phase<false, true>(F, args.in[0], nullptr, nullptr, nullptr, 0.f, args.in[1], Hb); }
    SEAM_G(0);
    if (hi - lo > 1) {
        const unsigned rk = F.MISC[10], uni = F.MISC[11];
        lmode = (__builtin_amdgcn_readfirstlane(uni) == 1u) && F.G == 256 && !MK_FORCE_GRID_BARRIERS;
        if (lmode) { F.gx = (int)bar.x; F.gr = (int)__builtin_amdgcn_readfirstlane(rk); cid = F.gr * 8 + F.gx; qcnt += 64 * (F.gx * 8 + (F.gr & 7)); }
    }
    F.grp = (F.G == 256);
    const int myslot = (lmode ? (F.gr & 7) : (cid & 7)) & 3;
#define CONV(q) do { if (l + 1 < NL && myslot == (q)) p0_items<1>(F, args, l + 1); } while (0)
    if (IN(1)) {
        const int fl = (int)blockIdx.x >> 5;
        if (fl < NL) {
            pg8::Gemm g{(const bf16*)(ws + WS_TPO + (size_t)fl * 4 * MiB), (const bf16*)(ws + WS_TGS + (size_t)fl * (MiB / 2)), D, PW, 256, PW, 256, 256}; pg8::StaticOrder S; S.init(D, PW, 32, (int)blockIdx.x & 31);
            pg8::EpiBf16S E{(bf16*)(ws + WS_W + (size_t)fl * LW_STRIDE + LW_WPS), 2048, nullptr, 1};
            pg8::gemm_phase<pg8::EpiBf16S, pg8::StaticOrder, PG8_ALIGN, PG8_SP2>(F.lds + RING_OFF, g, S, E);
        }
    }
    SEAM_G(1);
    if (lmode && STAGGER_US > 0) { const unsigned long long t0 = __builtin_amdgcn_s_memrealtime(), dt = (unsigned long long)(F.gx >> 1) * STAGGER_US * 100ull;
        while (__builtin_amdgcn_s_memrealtime() - t0 < dt) __builtin_amdgcn_s_sleep(8); }

    for (int s = 0; s < 2 * NL; ++s) {
        const int l = s >> 1, second = s & 1, pb = 2 + 11 * l + (second ? 8 : 0);
        unsigned char* wl = ws + WS_W + (size_t)l * LW_STRIDE;
        if (IN(pb)) {
            if (second) CONV(2);
            pg8::Gemm g{Hb, (const bf16*)(wl + (second ? LW_UP2 : LW_UP1)), M, NUP, D, D, D, 0}; pg8::StaticOrder S; S.init(M, NUP, F.G, cid);
            pg8::EpiSwiGLU E{ACT, FF};
            pg8::gemm_phase<pg8::EpiSwiGLU, pg8::StaticOrder, PG8_ALIGN, PG8_SP2>(F.lds + RING_OFF, g, S, E);
        }
        SEAM_L(pb);
        if (IN(pb + 1)) {
            if (second) CONV(3);
            pg8::Gemm g{ACT, (const bf16*)(wl + (second ? LW_DN2 : LW_DN1)), M, D, FF, FF, FF, 0}; pg8::StaticOrder S; S.init(M, D, F.G, cid);
            pg8::EpiBf16S E{Fb, D, nullptr, 0};
            pg8::gemm_phase<pg8::EpiBf16S, pg8::StaticOrder, PG8_ALIGN, PG8_SP2>(F.lds + RING_OFF, g, S, E);
        }
        SEAM_L(pb + 1);
        if (IN(pb + 2)) {
            const float* gpost = (second ? args.in[19] : args.in[4]) + (size_t)l * D;
            const float* gnext = second ? (l + 1 < NL ? args.in[1] + (size_t)(l + 1) * D : nullptr) : args.in[5] + (size_t)l * D;
            if (s == 0) norm_phase<false, true>(F, args.in[0], XB, Fb, gpost, 0.5f, gnext, Hb);
            else if (s == 2 * NL - 1) norm_phase<true, false>(F, XB, args.out, Fb, gpost, 0.5f, gnext, Hb);
            else norm_phase<true, true>(F, XB, XB, Fb, gpost, 0.5f, gnext, Hb);
        }
        if (second && l + 1 < NL) SEAM_G(pb + 2); else SEAM_L(pb + 2);
        if (!second) {
            if (IN(pb + 3)) {
                pg8::Gemm g{Hb, (const bf16*)(wl + LW_WIN), M, NIN, D, D, D, 0}; pg8::StaticOrder S; S.init(M, NIN, F.G, cid);
                pg8::EpiInProj E{(bf16*)(ws + ((l & 1) ? WS_P1 : WS_P)), Ub, VT, SGA, SGB, M, (float*)(ws + WS_SSQ)};
                pg8::gemm_phase<pg8::EpiInProj, pg8::StaticOrder, PG8_ALIGN, PG8_SP2>(F.lds + RING_OFF, g, S, E);
            }
            SEAM_P(pb + 3);
            if (IN(pb + 4)) {
                CONV(0);
                const int u0 = F.grp ? 32 * F.gx + 4 * (F.gr & 7) + (F.gr >> 3) : F.vcu;
                for (int u = u0; u < M / 64; u += F.G) pool_unit(F, (const bf16*)(ws + ((l & 1) ? WS_P1 : WS_P)), YZ, u);
                for (int u = u0; u < 2 * (M / 128); u += F.G)
                    sgu_unit(F, VT, Ub, YZ, (const float*)(ws + WS_SSQ), (const bf16*)(wl + LW_WG), args.in[12] + (size_t)l * 8 * 128, args.in[10] + (size_t)l * SW, u);
            }
            SEAM_L(pb + 4);
            if (IN(pb + 5)) {
                pg8::Gemm g{YZ, (const bf16*)(wl + LW_WPS), M, D, 2048, 2048, 2048, 0}; pg8::StaticOrder S; S.init(M, D, F.G, cid);
                pg8::EpiGate E{SGA, SGB, MM};
                pg8::gemm_phase<pg8::EpiGate, pg8::StaticOrder, PG8_ALIGN, PG8_SP2>(F.lds + RING_OFF, g, S, E);
            }
            SEAM_L(pb + 5);
            if (IN(pb + 6)) {
                CONV(1);
                pg8::Gemm g{MM, (const bf16*)(wl + LW_WO), M, D, D, D, D, 0}; pg8::StaticOrder S; S.init(M, D, F.G, cid);
                pg8::EpiBf16S E{Fb, D, nullptr, 0};
                pg8::gemm_phase<pg8::EpiBf16S, pg8::StaticOrder, PG8_ALIGN, PG8_SP2>(F.lds + RING_OFF, g, S, E);
            }
            SEAM_L(pb + 6);
            if (IN(pb + 7)) norm_phase<true, true>(F, XB, XB, Fb, args.in[15] + (size_t)l * D, 1.0f, args.in[16] + (size_t)l * D, Hb);
            SEAM_L(pb + 7);
        }
    }
#undef IN
#undef SEAM_G
#undef SEAM_P
#undef SEAM_L
#undef CONV
}

extern "C" void kernel_launch(void* const* d_in, const int* in_sizes, int n_in, void* d_out, int out_size, void* d_ws, size_t ws_size, hipStream_t stream) {
    static int grid = 0;
    if (grid == 0) {
        if (n_in != 20 || in_sizes[0] != M * D || out_size != M * D || ws_size < WS_END) { fprintf(stderr, "kernel_launch: shape/workspace mismatch: n_in %d in0 %d out %d ws %zu (need %zu)\n", n_in, n_in > 0 ? in_sizes[0] : -1, out_size, ws_size, (size_t)WS_END); grid = -1; return; }
        int dev = 0, cus = 0, per_cu = 0;
        if (hipGetDevice(&dev) != hipSuccess || hipDeviceGetAttribute(&cus, hipDeviceAttributeMultiprocessorCount, dev) != hipSuccess) { fprintf(stderr, "kernel_launch: device query failed\n"); grid = -1; return; }
        if (hipFuncSetAttribute((const void*)mk_fwd, hipFuncAttributeMaxDynamicSharedMemorySize, LDS_BYTES) != hipSuccess) { fprintf(stderr, "kernel_launch: hipFuncSetAttribute failed\n"); grid = -1; return; }
        if (hipOccupancyMaxActiveBlocksPerMultiprocessor(&per_cu, (const void*)mk_fwd, NWAVES * 64, LDS_BYTES) != hipSuccess || per_cu < 1) { fprintf(stderr, "kernel_launch: occupancy query reports %d workgroups per CU\n", per_cu); per_cu = 1; }
        (void)hipGetLastError();
        grid = cus;
    }
    if (grid < 0) return;
    if (hipMemsetAsync((char*)d_ws + WS_CTL, 0, CTL_ZERO_BYTES, stream) != hipSuccess) { fprintf(stderr, "kernel_launch: memset failed\n"); return; }
    Args a{};
    for (int i = 0; i < 20; ++i) a.in[i] = (const float*)d_in[i];
    a.out = (float*)d_out; a.ws = (unsigned char*)d_ws;
#if MK_ONE_LAUNCH
    a.ph_lo = 0; a.ph_hi = N_PHASES;
    hipLaunchKernelGGL(mk_fwd, dim3(grid), dim3(NWAVES * 64), LDS_BYTES, stream, a);
#else
    for (int p = 0; p < N_PHASES; ++p) { a.ph_lo = p; a.ph_hi = p + 1; hipLaunchKernelGGL(mk_fwd, dim3(grid), dim3(NWAVES * 64), LDS_BYTES, stream, a); }
#endif
    const hipError_t le = hipPeekAtLastError();
    if (le != hipSuccess) fprintf(stderr, "kernel_launch: launch failed: %s\n", hipGetErrorName(le));
}
```

```cpp
#include <hip/hip_runtime.h>
#include <cstdio>
#include <cstdint>

#ifndef STAGGER_US
#define STAGGER_US 0
#endif
#ifndef MK_FORCE_GRID_BARRIERS
#define MK_FORCE_GRID_BARRIERS 0
#endif
#ifndef W_AUX
#define W_AUX 19
#endif
#ifndef MK_ONE_LAUNCH
#define MK_ONE_LAUNCH 1
#endif

namespace pg8 {
#define PG8_LAS __attribute__((address_space(3)))
typedef unsigned short bf16_t;
typedef short bf16x8 __attribute__((ext_vector_type(8)));
typedef float f32x4 __attribute__((ext_vector_type(4)));
typedef float f32x2 __attribute__((ext_vector_type(2)));
typedef unsigned u32x4 __attribute__((ext_vector_type(4)));
typedef unsigned u32x2 __attribute__((ext_vector_type(2)));
constexpr int BM = 256, BK = 64, HALF = 128, HTB = HALF * BK * 2  , STAGE_BYTES = 8 * HTB, NXCD = 8, WGM = 8;

__host__ __device__ __forceinline__ int lds_byte(int r, int c) { const int st = (r >> 4) * 2 + (c >> 5), rr = r & 15, cc = c & 31, ob = rr * 64 + cc * 2; return st * 1024 + (ob ^ (((ob >> 9) & 1) << 5)); }
__host__ __device__ __forceinline__ void stage_rc(int b, int& R, int& C) { const int st = b / 1024, sb = b % 1024, swz = sb ^ (((sb >> 9) & 1) << 5); R = (st >> 1) * 16 + swz / 64; C = (st & 1) * 32 + (swz % 64) / 2; }
__host__ __device__ __forceinline__ int perm32(int rho) { const int n = rho >> 4, i = rho & 15; return 8 * (i >> 2) + 4 * n + (i & 3); }

__host__ __device__ __forceinline__ size_t blk_byte(int r, int c, int K) { return ((size_t)(r >> 7) * (size_t)(K >> 6) + (size_t)(c >> 6)) * 16384 + (size_t)lds_byte(r & 127, c & 63); }
struct Unit { int pm, pn; };
struct Gemm { const bf16_t* A; const bf16_t* Bt; int M, N, K, lda, ldb, a_pn_koff; const char* base = nullptr; };

struct StaticOrder {
    int nM, nN, nwg, G, c;
    __host__ __device__ void init(int M, int N, int G_, int c_) { nM = M / BM; nN = N / BM; nwg = nM * nN; G = G_; c = c_; }
    __host__ __device__ bool next(int i, Unit& u) const {
        const long L = (long)i * G + c; if (L >= nwg) return false;
        int wgid = (int)L; { const int q = nwg / NXCD, r = nwg % NXCD, xcd = wgid % NXCD, off = wgid / NXCD; wgid = (xcd < r ? xcd * (q + 1) : r * (q + 1) + (xcd - r) * q) + off; }
        const int nig = WGM * nN, gid = wgid / nig, fm = gid * WGM, gsz = (nM - fm) < WGM ? (nM - fm) : WGM;
        u.pm = fm + ((wgid % nig) % gsz); u.pn = (wgid % nig) / gsz; return true;
    }
    __device__ __forceinline__ void a_ready(const Unit&) const {}
    __device__ __forceinline__ void done(const Unit&) const {}
};

__device__ __forceinline__ unsigned cvt_pk_bf16(float lo, float hi) { unsigned r; asm volatile("v_cvt_pk_bf16_f32 %0, %1, %2" : "=v"(r) : "v"(lo), "v"(hi)); return r; }
__device__ __forceinline__ float row16_sum(float v) {
    v += __builtin_bit_cast(float, __builtin_amdgcn_update_dpp(0, __builtin_bit_cast(int, v), 0xB1, 0xF, 0xF, true));
    v += __builtin_bit_cast(float, __builtin_amdgcn_update_dpp(0, __builtin_bit_cast(int, v), 0x4E, 0xF, 0xF, true));
    v += __builtin_bit_cast(float, __builtin_amdgcn_update_dpp(0, __builtin_bit_cast(int, v), 0x141, 0xF, 0xF, true));
    v += __builtin_bit_cast(float, __builtin_amdgcn_update_dpp(0, __builtin_bit_cast(int, v), 0x140, 0xF, 0xF, true));
    return v;
}
__device__ __forceinline__ float bf_lo(unsigned w) { return __uint_as_float(w << 16); }
__device__ __forceinline__ float bf_hi(unsigned w) { return __uint_as_float(w & 0xffff0000u); }
__device__ __forceinline__ float sigmoid_f(float x) { return __builtin_amdgcn_rcpf(1.0f + __builtin_amdgcn_exp2f(-1.4426950408889634f * x)); }
__device__ __forceinline__ float silu_f(float x) { return x * sigmoid_f(x); }
__device__ __forceinline__ float gelu_f(float x) { const float y = 1.5957691216057308f * (x + 0.044715f * x * x * x); return x * sigmoid_f(y); }
__device__ __forceinline__ f32x4 exp2_4(const f32x4 z) { return (f32x4){__builtin_amdgcn_exp2f(z[0]), __builtin_amdgcn_exp2f(z[1]), __builtin_amdgcn_exp2f(z[2]), __builtin_amdgcn_exp2f(z[3])}; }
__device__ __forceinline__ f32x4 rcp_4(const f32x4 d) { return (f32x4){__builtin_amdgcn_rcpf(d[0]), __builtin_amdgcn_rcpf(d[1]), __builtin_amdgcn_rcpf(d[2]), __builtin_amdgcn_rcpf(d[3])}; }
__device__ __forceinline__ f32x4 sigmoid_4(const f32x4 x) { return rcp_4(exp2_4(x * -1.4426950408889634f) + 1.0f); }
__device__ __forceinline__ f32x4 gelu_4(const f32x4 x) { const float c1 = -1.4426950408889634f * 1.5957691216057308f, c2 = c1 * 0.044715f; const f32x4 z = x * ((x * x) * c2 + c1); return x * rcp_4(exp2_4(z) + 1.0f); }
__device__ __forceinline__ f32x4 swiglu_4(const f32x4 g, const f32x4 u) { return (g * u) * rcp_4(exp2_4(-g) + 1.0f); }
__device__ __forceinline__ u32x4 pack8(const f32x4 v0, const f32x4 v1) { u32x4 w; w.x = cvt_pk_bf16(v0[0], v0[1]); w.y = cvt_pk_bf16(v0[2], v0[3]); w.z = cvt_pk_bf16(v1[0], v1[1]); w.w = cvt_pk_bf16(v1[2], v1[3]); return w; }

struct EpiSwiGLU {
    static constexpr bool PERM = true, AFTER_DRAIN = false, SWAP = false, MID = false;
    bf16_t* O; int ldc;
    __device__ __forceinline__ bool swapped(const Unit&) const { return false; }
    __device__ __forceinline__ void mid(f32x4 (&)[2][2][4][2], const Unit&, int, int, int, int) const {}
    __device__ __forceinline__ void operator()(const f32x4 (&acc)[2][2][4][2], const Unit& u, int wr, int wc, int fr, int fq) const {
        const int row0 = u.pm * BM + wr * 64 + fr, col0 = u.pn * HALF + wc * 32 + 8 * fq;
#pragma unroll
        for (int ai = 0; ai < 2; ++ai)
#pragma unroll
            for (int m = 0; m < 4; ++m) { bf16_t* rowp = (bf16_t*)((char*)O + blk_byte(row0 + ai * HALF + m * 16, col0, ldc));
                const f32x4 v0 = swiglu_4(acc[ai][0][m][0], acc[ai][1][m][0]), v1 = swiglu_4(acc[ai][0][m][1], acc[ai][1][m][1]);
                *(u32x4*)rowp = pack8(v0, v1); }
    }
};
struct EpiBf16S {
    static constexpr bool PERM = true, AFTER_DRAIN = false, SWAP = false, MID = false;
    bf16_t* O; int ldc; const float* scale; int tiled;
    __device__ __forceinline__ bool swapped(const Unit&) const { return false; }
    __device__ __forceinline__ void mid(f32x4 (&)[2][2][4][2], const Unit&, int, int, int, int) const {}
    __device__ __forceinline__ void operator()(const f32x4 (&acc)[2][2][4][2], const Unit& u, int wr, int wc, int fr, int fq) const {
        const int row0 = u.pm * BM + wr * 64 + fr, col0 = u.pn * BM + wc * 32 + 8 * fq;
        f32x4 sv[2][2];
#pragma unroll
        for (int bj = 0; bj < 2; ++bj)
#pragma unroll
            for (int n = 0; n < 2; ++n) sv[bj][n] = scale ? *(const f32x4*)(scale + col0 + bj * HALF + 4 * n) : (f32x4){1.f, 1.f, 1.f, 1.f};
#pragma unroll
        for (int ai = 0; ai < 2; ++ai)
#pragma unroll
            for (int m = 0; m < 4; ++m) { const int r = row0 + ai * HALF + m * 16;
#pragma unroll
                for (int bj = 0; bj < 2; ++bj) { bf16_t* p = tiled ? (bf16_t*)((char*)O + blk_byte(r, col0 + bj * HALF, ldc)) : O + (size_t)r * ldc + col0 + bj * HALF;
                    *(u32x4*)p = pack8(acc[ai][bj][m][0] * sv[bj][0], acc[ai][bj][m][1] * sv[bj][1]); } }
    }
};
struct EpiInProj {
    static constexpr bool PERM = true, AFTER_DRAIN = false, SWAP = true, MID = false;
    bf16_t *P, *U, *VT, *SGA, *SGB; int Mrows; float* SSQ;
    __device__ __forceinline__ bool swapped(const Unit& u) const { return u.pn >= 8 && u.pn < 12; }
    __device__ __forceinline__ void mid(f32x4 (&)[2][2][4][2], const Unit&, int, int, int, int) const {}
    __device__ __forceinline__ void operator()(const f32x4 (&acc)[2][2][4][2], const Unit& u, int wr, int wc, int fr, int fq) const {
        bf16_t* base; int ldc, rbase, cbase, act;
        if (u.pn < 4)       { base = P;   ldc = 1024;  rbase = u.pm * BM;       cbase = u.pn * BM;        act = 0; }
        else if (u.pn < 8)  { base = U;   ldc = 1024;  rbase = u.pm * BM;       cbase = (u.pn - 4) * BM;  act = 1; }
        else if (u.pn < 12) { base = VT;  ldc = Mrows; rbase = (u.pn - 8) * BM; cbase = u.pm * BM;        act = 1; }
        else if (u.pn < 20) { base = SGA; ldc = 2048;  rbase = u.pm * BM;       cbase = (u.pn - 12) * BM; act = 2; }
        else                { base = SGB; ldc = 2048;  rbase = u.pm * BM;       cbase = (u.pn - 20) * BM; act = 2; }
        const int row0 = rbase + wr * 64 + fr, col0 = cbase + wc * 32 + 8 * fq;
        const bool vt = u.pn >= 8 && u.pn < 12;
        f32x4 sq[2][2];
#pragma unroll
        for (int bj = 0; bj < 2; ++bj)
#pragma unroll
            for (int n = 0; n < 2; ++n) sq[bj][n] = (f32x4){0.f, 0.f, 0.f, 0.f};
#pragma unroll
        for (int ai = 0; ai < 2; ++ai)
#pragma unroll
            for (int m = 0; m < 4; ++m) { bf16_t* rowp = base + (size_t)(row0 + ai * HALF + m * 16) * ldc + col0;
#pragma unroll
                for (int bj = 0; bj < 2; ++bj) { f32x4 v0 = acc[ai][bj][m][0], v1 = acc[ai][bj][m][1];
                    if (act == 1) { v0 = gelu_4(v0); v1 = gelu_4(v1);
                        if (vt) { sq[bj][0] += v0 * v0; sq[bj][1] += v1 * v1; } }
                    else if (act == 2) { v0 = sigmoid_4(v0); v1 = sigmoid_4(v1); }
                    *(u32x4*)(rowp + bj * HALF) = pack8(v0, v1); } }
        if (vt) {
#pragma unroll
            for (int bj = 0; bj < 2; ++bj)
#pragma unroll
                for (int n = 0; n < 2; ++n)
#pragma unroll
                    for (int j = 0; j < 4; ++j) sq[bj][n][j] = row16_sum(sq[bj][n][j]);
            if (fr == 0) { float* dst = SSQ + (size_t)((u.pn - 8) * 2 + wr) * Mrows + cbase + wc * 32 + 8 * fq;
#pragma unroll
                for (int bj = 0; bj < 2; ++bj)
#pragma unroll
                    for (int n = 0; n < 2; ++n) *(f32x4*)(dst + bj * HALF + 4 * n) = sq[bj][n]; }
        }
    }
};
struct EpiGate {
    static constexpr bool PERM = true, AFTER_DRAIN = false, SWAP = false, MID = true;
    const bf16_t *SGA, *SGB; bf16_t* O;
    __device__ __forceinline__ bool swapped(const Unit&) const { return false; }
    __device__ __forceinline__ void mid(f32x4 (&acc)[2][2][4][2], const Unit& u, int wr, int wc, int fr, int fq) const {
        const int row0 = u.pm * BM + wr * 64 + fr, col0 = u.pn * BM + wc * 32 + 8 * fq;
#pragma unroll
        for (int ai = 0; ai < 2; ++ai)
#pragma unroll
            for (int m = 0; m < 4; ++m) { const size_t off = (size_t)(row0 + ai * HALF + m * 16) * 2048 + col0;
#pragma unroll
                for (int bj = 0; bj < 2; ++bj) { const u32x4 a = *(const u32x4*)(SGA + off + bj * HALF), b = *(const u32x4*)(SGB + off + bj * HALF);
#pragma unroll
                    for (int k = 0; k < 4; ++k) { const float rl = bf_lo(a[k]) * __builtin_amdgcn_rcpf(fmaxf(bf_lo(b[k]), 1e-30f)), rh = bf_hi(a[k]) * __builtin_amdgcn_rcpf(fmaxf(bf_hi(b[k]), 1e-30f));
                        acc[ai][bj][m][k >> 1][(k & 1) * 2] *= rl; acc[ai][bj][m][k >> 1][(k & 1) * 2 + 1] *= rh; } } }
    }
    __device__ __forceinline__ void operator()(const f32x4 (&acc)[2][2][4][2], const Unit& u, int wr, int wc, int fr, int fq) const {
        const int row0 = u.pm * BM + wr * 64 + fr, col0 = u.pn * BM + wc * 32 + 8 * fq;
#pragma unroll
        for (int ai = 0; ai < 2; ++ai)
#pragma unroll
            for (int m = 0; m < 4; ++m) { const size_t off = (size_t)(row0 + ai * HALF + m * 16) * 2048 + col0;
#pragma unroll
                for (int bj = 0; bj < 2; ++bj) { const u32x4 b = *(const u32x4*)(SGB + off + bj * HALF);
                    const f32x4 s0 = {fmaxf(bf_lo(b[0]), 1e-30f), fmaxf(bf_hi(b[0]), 1e-30f), fmaxf(bf_lo(b[1]), 1e-30f), fmaxf(bf_hi(b[1]), 1e-30f)};
                    const f32x4 s1 = {fmaxf(bf_lo(b[2]), 1e-30f), fmaxf(bf_hi(b[2]), 1e-30f), fmaxf(bf_lo(b[3]), 1e-30f), fmaxf(bf_hi(b[3]), 1e-30f)};
                    *(u32x4*)((char*)O + blk_byte(row0 + ai * HALF + m * 16, col0 + bj * HALF, 2048)) = pack8(acc[ai][bj][m][0] * s0, acc[ai][bj][m][1] * s1); } }
    }
};

template <class Epi, class Sched, bool ALIGN_EPI = false, bool SP2 = false>
__device__ __forceinline__ void gemm_phase(PG8_LAS unsigned char* lds, const Gemm g, const Sched& S, const Epi& E) {
    int tid = threadIdx.x; asm volatile("" : "+v"(tid));
    const int wid = __builtin_amdgcn_readfirstlane(tid >> 6), lane = tid & 63, wr = wid >> 2, wc = wid & 3, fr = lane & 15, fq = lane >> 4;
    const int K = g.K, nt = K / BK;
    const __amdgpu_buffer_rsrc_t rs = __builtin_amdgcn_make_buffer_rsrc((void*)g.base, 0, 0xffffffff, 0x00020000);
    unsigned voffA[2], voffB[2];
#pragma unroll
    for (int i = 0; i < 2; ++i) { voffA[i] = (unsigned)(wid * 2048 + lane * 16 + i * 1024); voffB[i] = voffA[i]; }
    const size_t kstep = (size_t)HTB;
    const size_t hstepA = (size_t)g.lda * 256, hstepB = (size_t)g.ldb * 256;
    const size_t tstepA = 2 * hstepA, tstepB = 2 * hstepB;
    const unsigned ldsw = (unsigned)wid * 2048u;
    const int aoff = lds_byte(wr * 64 + fr, fq * 8);
    const int boff0 = lds_byte(wc * 32 + (Epi::PERM ? perm32(fr) : fr), fq * 8), boff1 = lds_byte(wc * 32 + (Epi::PERM ? perm32(16 + fr) : 16 + fr), fq * 8);
#define PG8_SA(b, h) (((b) * 2 + (h)) * HTB)
#define PG8_SB(b, h) ((4 + (b) * 2 + (h)) * HTB)
#define PG8_STAGE(bufoff, gbase, voff) do { const int _so = (int)(unsigned)((size_t)(gbase) - (size_t)g.base); PG8_LAS void* _l = (PG8_LAS void*)(lds + (bufoff) + ldsw); \
        __builtin_amdgcn_raw_ptr_buffer_load_lds(rs, _l, 16, (int)(voff)[0], _so, 0, 0); __builtin_amdgcn_raw_ptr_buffer_load_lds(rs, _l, 16, (int)(voff)[0], _so, 1024, 0); } while (0)
#define PG8_LDA(dst, b, h) do { _Pragma("unroll") for (int m = 0; m < 4; ++m) _Pragma("unroll") for (int k = 0; k < 2; ++k) dst[m][k] = *(const PG8_LAS bf16x8*)(lds + PG8_SA(b, h) + aoff + m * 2048 + k * 1024); } while (0)
#define PG8_LDB(dst, b, h) do { _Pragma("unroll") for (int n = 0; n < 2; ++n) _Pragma("unroll") for (int k = 0; k < 2; ++k) dst[n][k] = *(const PG8_LAS bf16x8*)(lds + PG8_SB(b, h) + (n ? boff1 : boff0) + k * 1024); } while (0)
#define PG8_MMA(ai, bj, At, Bt) do { __builtin_amdgcn_s_setprio(1); _Pragma("unroll") for (int m = 0; m < 4; ++m) _Pragma("unroll") for (int n = 0; n < 2; ++n) _Pragma("unroll") for (int k = 0; k < 2; ++k) \
        acc[ai][bj][m][n] = __builtin_amdgcn_mfma_f32_16x16x32_bf16(Bt[n][k], At[m][k], acc[ai][bj][m][n], 0, 0, 0); __builtin_amdgcn_s_setprio(0); } while (0)
#define PG8_WAIT_V(n) asm volatile("s_waitcnt vmcnt(" #n ")" ::: "memory")
#define PG8_WAIT_L(n) asm volatile("s_waitcnt lgkmcnt(" #n ")" ::: "memory")
#define PG8_BAR __builtin_amdgcn_s_barrier()
#define PG8_SCHED __builtin_amdgcn_sched_barrier(0)
#define PG8_UNIT_PTRS(u, pa, pb) do { const char* _a = (const char*)g.A + (size_t)(u).pm * tstepA + (size_t)(u).pn * (size_t)(g.a_pn_koff >> 6) * HTB; const char* _b = (const char*)g.Bt + (size_t)(u).pn * tstepB; \
        if (Epi::SWAP && E.swapped(u)) { pa = _b; pb = _a; } else { pa = _a; pb = _b; } } while (0)
    Unit cur, nxt; int ui = 0;
    if (!S.next(0, cur)) return;
    f32x4 acc[2][2][4][2];
#pragma unroll
    for (int a = 0; a < 2; ++a)
#pragma unroll
        for (int b = 0; b < 2; ++b)
#pragma unroll
            for (int m = 0; m < 4; ++m)
#pragma unroll
                for (int n = 0; n < 2; ++n) acc[a][b][m][n] = (f32x4){0.f, 0.f, 0.f, 0.f};
    bf16x8 At[4][2], B0[2][2], B1[2][2];
    const char* cA; const char* cB; PG8_UNIT_PTRS(cur, cA, cB);
    S.a_ready(cur);
    if constexpr (SP2) {
        PG8_STAGE(PG8_SB(0, 0), cB, voffB); PG8_STAGE(PG8_SB(0, 1), cB + hstepB, voffB); PG8_STAGE(PG8_SA(0, 0), cA, voffA); PG8_STAGE(PG8_SA(0, 1), cA + hstepA, voffA);
        if (wr == 1) PG8_BAR;
        PG8_WAIT_V(2); PG8_BAR;
        PG8_STAGE(PG8_SB(1, 0), cB + kstep, voffB); PG8_STAGE(PG8_SA(1, 0), cA + kstep, voffA); PG8_STAGE(PG8_SB(1, 1), cB + hstepB + kstep, voffB);
        PG8_WAIT_V(6); PG8_BAR;
    } else {
        PG8_STAGE(PG8_SB(0, 0), cB, voffB); PG8_STAGE(PG8_SA(0, 0), cA, voffA); PG8_STAGE(PG8_SB(0, 1), cB + hstepB, voffB); PG8_STAGE(PG8_SA(0, 1), cA + hstepA, voffA);
        if (wr == 1) PG8_BAR;
        PG8_WAIT_V(4); PG8_BAR;
        PG8_STAGE(PG8_SB(1, 0), cB + kstep, voffB); PG8_STAGE(PG8_SA(1, 0), cA + kstep, voffA); PG8_STAGE(PG8_SB(1, 1), cB + hstepB + kstep, voffB);
        PG8_WAIT_V(6); PG8_BAR;
    }
    for (;;) {
        const bool has_next = S.next(ui + 1, nxt);
        const char* nA = cA; const char* nB = cB; if (has_next) PG8_UNIT_PTRS(nxt, nA, nB);
        for (int t = 0; t < nt; t += 2) {
            const bool last = (t == nt - 2);
            const char* a1 = cA + (size_t)(t + 1) * kstep;
            const char* a2 = last ? nA : cA + (size_t)(t + 2) * kstep; const char* b2 = last ? nB : cB + (size_t)(t + 2) * kstep;
            const char* a3 = a2 + kstep; const char* b3 = b2 + kstep;
            if (last && has_next) S.a_ready(nxt);
            if constexpr (Epi::MID) { if (t == (nt >> 1)) { int tz = threadIdx.x; asm volatile("" : "+v"(tz)); const int w2 = __builtin_amdgcn_readfirstlane(tz >> 6), l2 = tz & 63; E.mid(acc, cur, w2 >> 2, w2 & 3, l2 & 15, l2 >> 4); } }
            if constexpr (SP2) {
            PG8_LDB(B0, 0, 0); PG8_LDB(B1, 0, 1); PG8_SCHED; PG8_LDA(At, 0, 0); PG8_STAGE(PG8_SA(1, 1), a1 + hstepA, voffA);
            PG8_WAIT_V(8); PG8_WAIT_L(0); PG8_BAR; PG8_MMA(0, 0, At, B0); PG8_MMA(0, 1, At, B1); PG8_BAR; PG8_SCHED;
            PG8_LDA(At, 0, 1); PG8_STAGE(PG8_SB(0, 0), b2, voffB); PG8_STAGE(PG8_SB(0, 1), b2 + hstepB, voffB); PG8_STAGE(PG8_SA(0, 0), a2, voffA);
            PG8_WAIT_V(8); PG8_WAIT_L(0); PG8_BAR; PG8_MMA(1, 0, At, B0); PG8_MMA(1, 1, At, B1); PG8_BAR; PG8_SCHED;
            PG8_LDB(B0, 1, 0); PG8_LDB(B1, 1, 1); PG8_SCHED; PG8_LDA(At, 1, 0); PG8_STAGE(PG8_SA(0, 1), a2 + hstepA, voffA);
            PG8_WAIT_V(8); PG8_WAIT_L(0); PG8_BAR; PG8_MMA(0, 0, At, B0); PG8_MMA(0, 1, At, B1); PG8_BAR; PG8_SCHED;
            PG8_LDA(At, 1, 1); PG8_STAGE(PG8_SB(1, 0), b3, voffB); PG8_STAGE(PG8_SB(1, 1), b3 + hstepB, voffB); PG8_STAGE(PG8_SA(1, 0), a3, voffA);
            PG8_WAIT_V(8); PG8_WAIT_L(0); PG8_BAR; PG8_MMA(1, 0, At, B0); PG8_MMA(1, 1, At, B1); PG8_BAR; PG8_SCHED;
            } else {
            PG8_LDB(B0, 0, 0); PG8_SCHED; PG8_LDA(At, 0, 0); PG8_STAGE(PG8_SA(1, 1), a1 + hstepA, voffA);
            PG8_WAIT_L(8); PG8_BAR; PG8_WAIT_L(0); PG8_MMA(0, 0, At, B0); PG8_BAR; PG8_SCHED;
            PG8_LDB(B1, 0, 1); PG8_STAGE(PG8_SB(0, 0), b2, voffB);
            PG8_BAR; PG8_WAIT_L(0); PG8_MMA(0, 1, At, B1); PG8_BAR;
            PG8_LDA(At, 0, 1); PG8_STAGE(PG8_SA(0, 0), a2, voffA);
            PG8_BAR; PG8_WAIT_L(0); PG8_MMA(1, 0, At, B0); PG8_BAR; PG8_SCHED;
            PG8_STAGE(PG8_SB(0, 1), b2 + hstepB, voffB);
            PG8_WAIT_V(6); PG8_BAR; PG8_MMA(1, 1, At, B1); PG8_BAR;
            PG8_LDB(B0, 1, 0); PG8_SCHED; PG8_LDA(At, 1, 0); PG8_STAGE(PG8_SA(0, 1), a2 + hstepA, voffA);
            PG8_WAIT_L(8); PG8_BAR; PG8_WAIT_L(0); PG8_MMA(0, 0, At, B0); PG8_BAR; PG8_SCHED;
            PG8_LDB(B1, 1, 1); PG8_STAGE(PG8_SB(1, 0), b3, voffB);
            PG8_BAR; PG8_WAIT_L(0); PG8_MMA(0, 1, At, B1); PG8_BAR;
            PG8_LDA(At, 1, 1); PG8_STAGE(PG8_SA(1, 0), a3, voffA);
            PG8_BAR; PG8_WAIT_L(0); PG8_MMA(1, 0, At, B0); PG8_BAR; PG8_SCHED;
            PG8_STAGE(PG8_SB(1, 1), b3 + hstepB, voffB);
            PG8_WAIT_V(6); PG8_BAR; PG8_MMA(1, 1, At, B1); PG8_BAR;
            }
        }
        if constexpr (ALIGN_EPI) { if (wr == 0) PG8_BAR; }
        { int tz = threadIdx.x; asm volatile("" : "+v"(tz)); const int w2 = __builtin_amdgcn_readfirstlane(tz >> 6), l2 = tz & 63; E(acc, cur, w2 >> 2, w2 & 3, l2 & 15, l2 >> 4); }
        S.done(cur);
        if (!has_next) break;
#pragma unroll
        for (int a = 0; a < 2; ++a)
#pragma unroll
            for (int b = 0; b < 2; ++b)
#pragma unroll
                for (int m = 0; m < 4; ++m)
#pragma unroll
                    for (int n = 0; n < 2; ++n) acc[a][b][m][n] = (f32x4){0.f, 0.f, 0.f, 0.f};
        cur = nxt; cA = nA; cB = nB; ++ui;
        if constexpr (ALIGN_EPI) { if (wr == 1) PG8_BAR; }
    }
    PG8_WAIT_V(0);
    if constexpr (!ALIGN_EPI) { if (wr == 0) PG8_BAR; }
    PG8_BAR;
#undef PG8_SA
#undef PG8_SB
#undef PG8_STAGE
#undef PG8_LDA
#undef PG8_LDB
#undef PG8_MMA
#undef PG8_WAIT_V
#undef PG8_WAIT_L
#undef PG8_BAR
#undef PG8_SCHED
#undef PG8_UNIT_PTRS
}
}

constexpr int NWAVES = 8;
constexpr int BATCH = 4, SEQ = 4096, D = 2048, FF = 5632, NUP = 2 * FF, NIN = 7168, PW = 1024, SW = 1024, NL = 4;
constexpr int M = BATCH * SEQ;
constexpr float EPS = 1e-6f;
constexpr int N_PHASES = 2 + 11 * NL;

constexpr size_t MiB = 1u << 20;
constexpr size_t WS_CTL = 0, CTL_ZERO_BYTES = 1 * MiB;
constexpr size_t WS_W = 2 * MiB;
constexpr size_t LW_UP1 = 0, LW_DN1 = 44 * MiB, LW_WIN = 66 * MiB, LW_WG = 94 * MiB, LW_WPS = 94 * MiB + MiB / 2, LW_WO = 102 * MiB + MiB / 2, LW_UP2 = 110 * MiB + MiB / 2, LW_DN2 = 154 * MiB + MiB / 2;
constexpr size_t LW_STRIDE = 176 * MiB + MiB / 2;
static_assert((size_t)NUP * D * 2 == 44 * MiB && (size_t)D * FF * 2 == 22 * MiB && (size_t)NIN * D * 2 == 28 * MiB && (size_t)1024 * 256 * 2 == MiB / 2 && (size_t)D * D * 2 == 8 * MiB, "weight sizes");
constexpr size_t WS_H = WS_W + NL * LW_STRIDE;
constexpr size_t WS_F = WS_H + 64 * MiB;
constexpr size_t WS_R = WS_F + 64 * MiB;
constexpr size_t WS_P = WS_R, WS_U = WS_R + 32 * MiB, WS_VT = WS_R + 64 * MiB, WS_P1 = WS_R + 96 * MiB, WS_SGA = WS_R + 128 * MiB, WS_SGB = WS_R + 192 * MiB, WS_YZ = WS_R + 256 * MiB, WS_MM = WS_R + 320 * MiB;
constexpr size_t WS_ACT = WS_R + 384 * MiB;
constexpr size_t WS_SSQ = WS_ACT + 176 * MiB;
constexpr size_t WS_XB = WS_SSQ + 1 * MiB;
constexpr size_t WS_END = WS_XB + 64 * MiB;
constexpr size_t WS_TPO = WS_R, WS_TGS = WS_R + 16 * MiB;
static_assert((size_t)M * FF * 2 == 176 * MiB && WS_H == 708 * MiB, "ws map");
constexpr int CW_BAR = 4096, CW_QUAD = 8192;

constexpr int RING_OFF = 0, RING_BYTES = 131072;
constexpr int LDSCTL_OFF = RING_BYTES, MISC_OFF = LDSCTL_OFF + 320;
constexpr int LDS_BYTES = 147456;
static_assert(MISC_OFF + 128 <= LDS_BYTES, "LDS map");

#define GAS __attribute__((address_space(1)))
#define LAS __attribute__((address_space(3)))
typedef unsigned short bf16;
typedef unsigned v4u __attribute__((ext_vector_type(4)));
typedef unsigned v2u __attribute__((ext_vector_type(2)));
typedef float f32x4 __attribute__((ext_vector_type(4)));
typedef short bf16x8 __attribute__((ext_vector_type(8)));
typedef GAS unsigned gu32;
#define RLX_AGENT __ATOMIC_RELAXED, __HIP_MEMORY_SCOPE_AGENT
#define LDS_WAIT() asm volatile("s_waitcnt lgkmcnt(0)" ::: "memory")
#define VM_WAIT() asm volatile("s_waitcnt vmcnt(0)" ::: "memory")
__device__ __forceinline__ unsigned f2bf(float f) { unsigned u = __builtin_bit_cast(unsigned, f); return (u + 0x7fffu + ((u >> 16) & 1u)) >> 16; }
__device__ __forceinline__ unsigned pk2(float lo, float hi) { return pg8::cvt_pk_bf16(lo, hi); }
__device__ __forceinline__ float bflo(unsigned w) { return __uint_as_float(w << 16); }
__device__ __forceinline__ float bfhi(unsigned w) { return __uint_as_float(w & 0xffff0000u); }

#define XB_TMO      128
#define XB_XCNT(j)  (256  + 64 * (j))
#define XB_XSUB(j)  (1280 + 64 * (j))
#define XB_XGEN(j)  (2304 + 64 * (j))
#define XB_TOP      3328
#define XB_TOPGEN   3392
#define XCD_BAR_WORDS 3456
#define XB_PTOP(p)    (3456 + 128 * (p))
#define XB_PTOPGEN(p) (3520 + 128 * (p))
#define XB_SPIN_CAP (1u << 18)

__device__ __forceinline__ unsigned xb_ld(unsigned* p)              { return __hip_atomic_load(p, __ATOMIC_RELAXED, __HIP_MEMORY_SCOPE_AGENT); }
__device__ __forceinline__ unsigned xb_add(unsigned* p, unsigned v) { return __hip_atomic_fetch_add(p, v, __ATOMIC_RELAXED, __HIP_MEMORY_SCOPE_AGENT); }
__device__ __forceinline__ unsigned xb_xcc_id() { return (unsigned)__builtin_amdgcn_s_getreg((3 << 11) | 20) & 0xFu; }
#define XB_SPIN(cond, bar) do { unsigned _sp = 0; while (cond) { __builtin_amdgcn_s_sleep(1); \
    if ((++_sp & 255u) == 0u) { if (xb_ld(&(bar)[XB_TMO])) break; if (_sp > XB_SPIN_CAP) { atomicAdd(&(bar)[XB_TMO], 1u); break; } } } } while (0)

struct XcdBarrier {
    unsigned* bar; unsigned x;
    volatile LAS unsigned* st;
};
__device__ __forceinline__ XcdBarrier xcd_barrier_post(unsigned* bar, volatile LAS unsigned* st) {
    XcdBarrier b; b.bar = bar; b.x = xb_xcc_id(); b.st = st;
    if (threadIdx.x == 0) st[2] = xb_add(&bar[XB_XCNT(b.x)], 1u);
    return b;
}
__device__ __forceinline__ void xcd_barrier_complete(unsigned* bar, unsigned x, unsigned& nloc, unsigned& nx, unsigned& uni) {
    const unsigned G = gridDim.x * gridDim.y * gridDim.z;
    unsigned sum, cnt, mine, sp = 0u;
    for (;;) {
        sum = 0u; cnt = 0u; mine = 0u; uni = 1u;
#pragma unroll
        for (unsigned j = 0; j < 16; ++j) { const unsigned c = xb_ld(&bar[XB_XCNT(j)]); sum += c; cnt += (c > 0u) ? 1u : 0u; mine = (j == x) ? c : mine; if (c != (j < 8u ? 32u : 0u)) uni = 0u; }
        if (sum == G) break;
        __builtin_amdgcn_s_sleep(1);
        if ((++sp & 255u) == 0u) { if (xb_ld(&bar[XB_TMO])) break; if (sp > XB_SPIN_CAP) { atomicAdd(&bar[XB_TMO], 1u); break; } }
    }
    nloc = mine > 0u ? mine : 1u; nx = cnt > 0u ? cnt : 1u; if (sum != G) uni = 0u;
}
__device__ __forceinline__ void xcd_barrier(const XcdBarrier& b, const bool pair) {
    asm volatile("s_waitcnt vmcnt(0)" ::: "memory");
    __syncthreads();
    if (threadIdx.x == 0) {
        unsigned* bar = b.bar;
        __builtin_amdgcn_s_waitcnt(0);
        unsigned nloc = b.st[0], nx = b.st[1];
        if (nloc == 0u) { unsigned uni; xcd_barrier_complete(bar, b.x, nloc, nx, uni); b.st[0] = nloc; b.st[1] = nx; b.st[3] = uni; }
        const unsigned old = xb_add(&bar[XB_XSUB(b.x)], 1u);
        const unsigned gen = old / nloc;
        if (old + 1u == (gen + 1u) * nloc) {
            __builtin_amdgcn_fence(__ATOMIC_RELEASE, "agent");
            asm volatile("s_waitcnt vmcnt(0)" ::: "memory");
            if (!pair) {
            const unsigned og = xb_add(&bar[XB_TOP], 1u);
            const unsigned tg = og / nx;
            if (og + 1u == (tg + 1u) * nx) xb_add(&bar[XB_TOPGEN], 1u);
            else XB_SPIN(xb_ld(&bar[XB_TOPGEN]) == tg, bar);
            } else {
            unsigned* top = &bar[XB_PTOP(b.x >> 1)]; unsigned* tgen = &bar[XB_PTOPGEN(b.x >> 1)];
            const unsigned og = xb_add(top, 1u);
            const unsigned tg = og / 2u;
            if (og + 1u == (tg + 1u) * 2u) xb_add(tgen, 1u);
            else XB_SPIN(xb_ld(tgen) == tg, bar);
            }
            __builtin_amdgcn_fence(__ATOMIC_ACQUIRE, "agent");
            xb_add(&bar[XB_XGEN(b.x)], 1u);
            asm volatile("s_waitcnt vmcnt(0)" ::: "memory");
        } else {
            XB_SPIN(xb_ld(&bar[XB_XGEN(b.x)]) == gen, bar);
            __builtin_amdgcn_fence(__ATOMIC_ACQUIRE, "agent");
            asm volatile("s_waitcnt vmcnt(0)" ::: "memory");
        }
    }
    __syncthreads();
}

__device__ __forceinline__ void quad_barrier(unsigned* cnt, unsigned* tmo) {
    asm volatile("s_waitcnt vmcnt(0)" ::: "memory");
    __syncthreads();
    if (threadIdx.x == 0) {
        __builtin_amdgcn_s_waitcnt(0);
        const unsigned old = xb_add(cnt, 1u), target = (old / 4u + 1u) * 4u;
        unsigned sp = 0;
        while (xb_ld(cnt) < target) { __builtin_amdgcn_s_sleep(1); if ((++sp & 255u) == 0u) { if (xb_ld(tmo)) break; if (sp > XB_SPIN_CAP) { atomicAdd(tmo, 1u); break; } } }
        __builtin_amdgcn_fence(__ATOMIC_ACQUIRE, "agent");
        asm volatile("s_waitcnt vmcnt(0)" ::: "memory");
    }
    __syncthreads();
}

struct Frame {
    LAS unsigned char* lds;
    volatile LAS unsigned* MISC;
    gu32* ctl;
    int vcu, G;
    int gx, gr, grp;
};
struct Lane { int tid, lane, wave; };
__device__ __forceinline__ Lane opaque_lane() { int t = threadIdx.x; asm volatile("" : "+v"(t)); Lane q; q.tid = t; q.lane = t & 63; q.wave = __builtin_amdgcn_readfirstlane(t >> 6); return q; }
__device__ __forceinline__ float wave_sum(float v) {
    v = pg8::row16_sum(v);
    const float r0 = __builtin_bit_cast(float, __builtin_amdgcn_readlane(__builtin_bit_cast(int, v), 0)), r1 = __builtin_bit_cast(float, __builtin_amdgcn_readlane(__builtin_bit_cast(int, v), 16));
    const float r2 = __builtin_bit_cast(float, __builtin_amdgcn_readlane(__builtin_bit_cast(int, v), 32)), r3 = __builtin_bit_cast(float, __builtin_amdgcn_readlane(__builtin_bit_cast(int, v), 48));
    return (r0 + r1) + (r2 + r3);
}

__device__ __forceinline__ void p0_transpose_item(const float* __restrict__ W, int Ns, bf16* __restrict__ WT, int dld, int koff, int mode, LAS float* scr, int item, int lane) {
    const int nblk = Ns / 64, kb = item / nblk, nb = item % nblk, k0 = 64 * kb, n0 = 64 * nb;
    const int n0s = mode ? (((n0 >> 7) & 1) * FF + (n0 >> 8) * 128 + (n0 & 127)) : n0;
    const __amdgpu_buffer_rsrc_t rs = __builtin_amdgcn_make_buffer_rsrc((void*)W, 0, 0x7fffffff, 0x00020000);
    const int voff = (int)(((size_t)k0 * Ns + n0s + lane) * 4), rowb = Ns * 4;
    float wv[64];
#pragma unroll
    for (int k = 0; k < 64; ++k) wv[k] = __builtin_bit_cast(float, __builtin_amdgcn_raw_buffer_load_b32(rs, voff, k * rowb, W_AUX));
    LAS unsigned* scu = (LAS unsigned*)scr;
    const float sc = mode ? (((n0 >> 7) & 1) ? 0.6931471805599453f : 1.4426950408889634f) : 1.0f;
#pragma unroll
    for (int i = 0; i < 32; ++i) scu[i * 64 + (lane ^ (((i >> 2) & 3) << 3))] = pk2(wv[2 * i] * sc, wv[2 * i + 1] * sc);
    LDS_WAIT(); asm volatile("" ::: "memory");
    const int rr = lane >> 2, ch = lane & 3;
#pragma unroll
    for (int j = 0; j < 8; ++j) { const int n = 16 * (j >> 1) + rr, kk = (j & 1) * 32 + 8 * ch; const LAS unsigned* sp = scu + (kk >> 1) * 64 + (n ^ (8 * ch));
        v4u o; o.x = sp[0 * 64]; o.y = sp[1 * 64]; o.z = sp[2 * 64]; o.w = sp[3 * 64];
        *(v4u*)((char*)WT + pg8::blk_byte(n0 + n, koff + k0 + kk, dld)) = o; }
    LDS_WAIT(); asm volatile("" ::: "memory");
}

struct Args { const float* in[20]; float* out; unsigned char* ws; int ph_lo, ph_hi; };

template <int MODE>
__device__ __forceinline__ void p0_items(Frame& F, const Args& args, int lsel) {
    const Lane T = opaque_lane();
    LAS float* scr = (LAS float*)(F.lds + RING_OFF + T.wave * 16384);
    const int gw = F.vcu * NWAVES + T.wave, NGW = F.G * NWAVES;
    constexpr int I_UP = (D / 64) * (NUP / 64), I_DN = (FF / 64) * (D / 64), I_IN = (D / 64) * (NIN / 64), I_G = 4 * 256 * 256 / 2048, I_WS = 8 * 128 * 128 / 2048, I_PO = (PW / 64) * (D / 64), I_SO = I_PO, I_O = (D / 64) * (D / 64);
    constexpr int PER_LAYER = 2 * I_UP + 2 * I_DN + I_IN + I_G + I_WS + I_PO + I_SO + I_O;
    constexpr int OFF_G = I_UP + I_DN + I_IN, OFF_PO = OFF_G + I_G + I_WS, I_SMALL = I_G + I_PO;
    constexpr int NITEMS = MODE == 0 ? PER_LAYER + (NL - 1) * I_SMALL : PER_LAYER - I_SMALL;
    for (int it = gw; it < NITEMS; it += NGW) {
        int l, r;
        if constexpr (MODE == 0) { if (it < PER_LAYER) { l = 0; r = it; } else { const int j = it - PER_LAYER, q = j % I_SMALL; l = 1 + j / I_SMALL; r = q < I_G ? OFF_G + q : OFF_PO + (q - I_G); } }
        else { l = lsel; r = it; if (r >= OFF_G) r += I_G; if (r >= OFF_PO) r += I_PO; }
        unsigned char* wl = args.ws + WS_W + (size_t)l * LW_STRIDE;
        if (r < I_UP) { p0_transpose_item(args.in[2] + (size_t)l * D * NUP, NUP, (bf16*)(wl + LW_UP1), D, 0, 1, scr, r, T.lane); continue; } r -= I_UP;
        if (r < I_DN) { p0_transpose_item(args.in[3] + (size_t)l * FF * D, D, (bf16*)(wl + LW_DN1), FF, 0, 0, scr, r, T.lane); continue; } r -= I_DN;
        if (r < I_IN) { p0_transpose_item(args.in[6] + (size_t)l * D * NIN, NIN, (bf16*)(wl + LW_WIN), D, 0, 0, scr, r, T.lane); continue; } r -= I_IN;
        if (r < I_G)  {
                        const float* src = args.in[7] + (size_t)l * 262144 + (size_t)r * 2048; const float* sc = args.in[8] + (size_t)l * PW + (r >> 5) * 256 + 4 * T.lane;
                        const f32x4 sv = *(const f32x4*)sc;
#pragma unroll
                        for (int p = 0; p < 8; ++p) { const f32x4 v = *(const f32x4*)(src + p * 256 + 4 * T.lane) * sv; v2u o; o.x = pk2(v.x, v.y); o.y = pk2(v.z, v.w);
                            *(v2u*)((char*)(args.ws + WS_TGS + (size_t)l * (MiB / 2)) + pg8::blk_byte(8 * r + p, 4 * T.lane, 256)) = o; }
                        continue; } r -= I_G;
        if (r < I_WS) {
                        const float* src = args.in[11] + (size_t)l * 131072 + (size_t)r * 2048; bf16* dst = (bf16*)(wl + LW_WG) + (size_t)r * 2048;
#pragma unroll
                        for (int p = 0; p < 8; ++p) { const int t = (16 * r + 2 * p + (T.lane >> 5)) & 127, s0 = (4 * T.lane) & 127; const f32x4 v = *(const f32x4*)(src + p * 256 + 4 * T.lane);
                            v2u o; o.x = pk2(s0 <= t ? v.x : 0.f, s0 + 1 <= t ? v.y : 0.f); o.y = pk2(s0 + 2 <= t ? v.z : 0.f, s0 + 3 <= t ? v.w : 0.f); *(v2u*)(dst + p * 256 + 4 * T.lane) = o; }
                        continue; } r -= I_WS;
        if (r < I_PO) { p0_transpose_item(args.in[9] + (size_t)l * PW * D, D, (bf16*)(args.ws + WS_TPO + (size_t)l * 4 * MiB), 1024, 0, 0, scr, r, T.lane); continue; } r -= I_PO;
        if (r < I_SO) { p0_transpose_item(args.in[13] + (size_t)l * SW * D, D, (bf16*)(wl + LW_WPS), 2048, 1024, 0, scr, r, T.lane); continue; } r -= I_SO;
        if (r < I_O)  { p0_transpose_item(args.in[14] + (size_t)l * D * D, D, (bf16*)(wl + LW_WO), D, 0, 0, scr, r, T.lane); continue; } r -= I_O;
        if (r < I_UP) { p0_transpose_item(args.in[17] + (size_t)l * D * NUP, NUP, (bf16*)(wl + LW_UP2), D, 0, 1, scr, r, T.lane); continue; } r -= I_UP;
        p0_transpose_item(args.in[18] + (size_t)l * FF * D, D, (bf16*)(wl + LW_DN2), FF, 0, 0, scr, r, T.lane);
    }
    __syncthreads();
}

typedef _Float16 h16x2 __attribute__((ext_vector_type(2)));
typedef float f32x2_t __attribute__((ext_vector_type(2)));
__device__ __forceinline__ unsigned pk_h2(float a, float b) { const h16x2 h = __builtin_convertvector((f32x2_t){a, b}, h16x2); return __builtin_bit_cast(unsigned, h); }
__device__ __forceinline__ f32x2_t un_h2(unsigned w) { return __builtin_convertvector(__builtin_bit_cast(h16x2, w), f32x2_t); }
template <bool XIN_BF, bool XOUT_BF>
__device__ __forceinline__ void norm_phase(Frame& F, const void* xin_, void* xout_, const bf16* Fb, const float* gpost, float wgt, const float* gnext, bf16* H) {
    const float* xin = (const float*)xin_; float* xout = (float*)xout_; const bf16* xinb = (const bf16*)xin_; bf16* xoutb = (bf16*)xout_;
    const Lane T = opaque_lane();
    const int gw = F.vcu * NWAVES + T.wave, NGW = F.G * NWAVES, lw = 256 * (F.gr & 7) + 64 * (F.gr >> 3) + T.wave;
#define NORM_ROW(i) (F.grp ? (2048 * F.gx + lw + 8 * (i)) : (gw + NGW * (i)))
    const int nrows = F.grp ? 8 : (M - gw + NGW - 1) / NGW;
    f32x4 gp[8], gn[8];
#pragma unroll
    for (int j = 0; j < 8; ++j) { gp[j] = Fb ? ((const f32x4*)gpost)[64 * j + T.lane] : (f32x4){0.f, 0.f, 0.f, 0.f}; gn[j] = gnext ? ((const f32x4*)gnext)[64 * j + T.lane] : (f32x4){0.f, 0.f, 0.f, 0.f}; }
    f32x4 x[8], xn[8]; v2u fw[8], fn[8], xbn[8];
    { const int m = NORM_ROW(0);
      if constexpr (XIN_BF) { const v2u* xr = (const v2u*)(xinb + (size_t)m * D) + T.lane;
#pragma unroll
          for (int j = 0; j < 8; ++j) xbn[j] = __builtin_nontemporal_load(xr + 64 * j); }
      else { const f32x4* xr = (const f32x4*)(xin + (size_t)m * D) + T.lane;
#pragma unroll
          for (int j = 0; j < 8; ++j) xn[j] = __builtin_nontemporal_load(xr + 64 * j); }
      if (Fb) { const v2u* fr = (const v2u*)(Fb + (size_t)m * D) + T.lane;
#pragma unroll
          for (int j = 0; j < 8; ++j) fn[j] = __builtin_nontemporal_load(fr + 64 * j); } }
    for (int i = 0; i < nrows; ++i) {
        const int m = NORM_ROW(i);
#pragma unroll
        for (int j = 0; j < 8; ++j) { if constexpr (XIN_BF) { const v2u w = xbn[j]; const f32x2_t a = un_h2(w.x), b = un_h2(w.y); x[j] = (f32x4){a.x, a.y, b.x, b.y}; } else x[j] = xn[j]; fw[j] = fn[j]; }
        if (i + 1 < nrows) { const int m2 = NORM_ROW(i + 1);
            if constexpr (XIN_BF) { const v2u* xr = (const v2u*)(xinb + (size_t)m2 * D) + T.lane;
#pragma unroll
                for (int j = 0; j < 8; ++j) xbn[j] = __builtin_nontemporal_load(xr + 64 * j); }
            else { const f32x4* xr = (const f32x4*)(xin + (size_t)m2 * D) + T.lane;
#pragma unroll
                for (int j = 0; j < 8; ++j) xn[j] = __builtin_nontemporal_load(xr + 64 * j); }
            if (Fb) { const v2u* fr = (const v2u*)(Fb + (size_t)m2 * D) + T.lane;
#pragma unroll
                for (int j = 0; j < 8; ++j) fn[j] = __builtin_nontemporal_load(fr + 64 * j); } }
        if (Fb) {
            f32x4 f[8]; float ss = 0.f;
#pragma unroll
            for (int j = 0; j < 8; ++j) { const v2u w = fw[j]; f[j] = (f32x4){bflo(w.x), bfhi(w.x), bflo(w.y), bfhi(w.y)}; ss += (f[j].x * f[j].x + f[j].y * f[j].y) + (f[j].z * f[j].z + f[j].w * f[j].w); }
            const float rs = wgt * __builtin_amdgcn_rsqf(wave_sum(ss) * (1.f / D) + EPS);
            if constexpr (XOUT_BF) { v2u* xo = (v2u*)(xoutb + (size_t)m * D) + T.lane;
#pragma unroll
                for (int j = 0; j < 8; ++j) { x[j] = x[j] + (f[j] * rs) * gp[j]; v2u w; w.x = pk_h2(x[j].x, x[j].y); w.y = pk_h2(x[j].z, x[j].w); __builtin_nontemporal_store(w, xo + 64 * j); } }
            else { f32x4* xo = (f32x4*)(xout + (size_t)m * D) + T.lane;
#pragma unroll
                for (int j = 0; j < 8; ++j) { x[j] = x[j] + (f[j] * rs) * gp[j]; __builtin_nontemporal_store(x[j], xo + 64 * j); } }
        }
        if (gnext) {
            float s2 = 0.f;
#pragma unroll
            for (int j = 0; j < 8; ++j) s2 += (x[j].x * x[j].x + x[j].y * x[j].y) + (x[j].z * x[j].z + x[j].w * x[j].w);
            const float rx = __builtin_amdgcn_rsqf(wave_sum(s2) * (1.f / D) + EPS);
#pragma unroll
            for (int j = 0; j < 8; ++j) { const f32x4 v = (x[j] * rx) * gn[j]; v2u w; w.x = pg8::cvt_pk_bf16(v.x, v.y); w.y = pg8::cvt_pk_bf16(v.z, v.w);
                *(v2u*)((char*)H + pg8::blk_byte(m, 256 * j + 4 * T.lane, D)) = w; }
        }
    }
#undef NORM_ROW
}

template <int W> __device__ __forceinline__ void pool_body(const bf16* __restrict__ P, bf16* __restrict__ DP, int ms, int c0) {
    const int tl0 = ms & (SEQ - 1);
    v4u row[W - 1 + 16];
#pragma unroll
    for (int k = 0; k < W - 1; ++k) { const int j = W - 1 - k; row[k] = (tl0 - j >= 0) ? __builtin_nontemporal_load((const v4u*)(P + (size_t)(ms - j) * PW + c0)) : (v4u){0u, 0u, 0u, 0u}; }
#pragma unroll
    for (int i = 0; i < 16; ++i) row[W - 1 + i] = __builtin_nontemporal_load((const v4u*)(P + (size_t)(ms + i) * PW + c0));
    float S[8];
#pragma unroll
    for (int k = 0; k < 8; ++k) S[k] = 0.f;
#pragma unroll
    for (int k = 0; k < W - 1; ++k)
#pragma unroll
        for (int q = 0; q < 4; ++q) { S[2 * q] += bflo(row[k][q]); S[2 * q + 1] += bfhi(row[k][q]); }
#pragma unroll
    for (int i = 0; i < 16; ++i) {
        float cur[8], d[8];
#pragma unroll
        for (int q = 0; q < 4; ++q) { cur[2 * q] = bflo(row[W - 1 + i][q]); cur[2 * q + 1] = bfhi(row[W - 1 + i][q]); }
        const int cnt = (tl0 + i + 1) < W ? (tl0 + i + 1) : W; const float inv = 1.0f / (float)cnt;
#pragma unroll
        for (int k = 0; k < 8; ++k) { S[k] += cur[k]; d[k] = S[k] * inv - cur[k]; }
        v4u o; o.x = pg8::cvt_pk_bf16(d[0], d[1]); o.y = pg8::cvt_pk_bf16(d[2], d[3]); o.z = pg8::cvt_pk_bf16(d[4], d[5]); o.w = pg8::cvt_pk_bf16(d[6], d[7]);
        *(v4u*)((char*)DP + pg8::blk_byte(ms + i, c0, 2048)) = o;
#pragma unroll
        for (int q = 0; q < 4; ++q) { S[2 * q] -= bflo(row[i][q]); S[2 * q + 1] -= bfhi(row[i][q]); }
    }
}
__device__ __forceinline__ void pool_unit(Frame& F, const bf16* __restrict__ P, bf16* __restrict__ DP, int unit) {
    const Lane T = opaque_lane();
    const int g = T.wave & 3, tq = 2 * (T.wave >> 2) + (T.lane >> 5), c0 = g * 256 + (T.lane & 31) * 8, ms = unit * 64 + tq * 16;
    if (g == 0) pool_body<2>(P, DP, ms, c0); else if (g == 1) pool_body<4>(P, DP, ms, c0); else if (g == 2) pool_body<8>(P, DP, ms, c0); else pool_body<16>(P, DP, ms, c0);
}

__device__ __forceinline__ void sgu_unit(Frame& F, const bf16* __restrict__ VT, const bf16* __restrict__ U, bf16* __restrict__ YZ, const float* __restrict__ SSQ, const bf16* __restrict__ WSB,
                                         const float* __restrict__ bs, const float* __restrict__ gain, int unit) {
    const Lane T = opaque_lane();
    const int hg = unit & 1, cn = unit >> 1, m0 = cn * 128;
    LAS float* rstd = (LAS float*)(F.lds + RING_OFF);
    if (T.tid < 128) { float sm = 0.f;
#pragma unroll
        for (int k = 0; k < 8; ++k) sm += SSQ[(size_t)k * M + m0 + T.tid];
        rstd[T.tid] = __builtin_amdgcn_rsqf(sm * (1.f / SW) + EPS); }
    __syncthreads();
    const int fr = T.lane & 15, fq = T.lane >> 4;
    float rs[4][8];
#pragma unroll
    for (int ks = 0; ks < 4; ++ks) { const f32x4 a = *(const LAS f32x4*)(rstd + ks * 32 + 8 * fq), b = *(const LAS f32x4*)(rstd + ks * 32 + 8 * fq + 4);
#pragma unroll
        for (int i = 0; i < 4; ++i) { rs[ks][i] = a[i]; rs[ks][4 + i] = b[i]; } }
    __syncthreads();
    const int h = hg * 4 + (T.wave >> 1);
    const bf16* Wh = WSB + (size_t)h * 16384;
    float bias[8];
#pragma unroll
    for (int jt = 0; jt < 8; ++jt) bias[jt] = bs[h * 128 + 16 * jt + fr];
#pragma unroll
    for (int pr = 0; pr < 2; ++pr) {
        const int cb = h * 128 + (T.wave & 1) * 64 + pr * 32, chA = cb + 8 * (fr >> 2) + (fr & 3);
        bf16x8 xa[4], xb[4];
#pragma unroll
        for (int ks = 0; ks < 4; ++ks) { const v4u qa = __builtin_nontemporal_load((const v4u*)(VT + (size_t)chA * M + m0 + ks * 32 + 8 * fq)), qb = __builtin_nontemporal_load((const v4u*)(VT + (size_t)(chA + 4) * M + m0 + ks * 32 + 8 * fq));
            v4u oa, ob;
#pragma unroll
            for (int k = 0; k < 4; ++k) { oa[k] = pg8::cvt_pk_bf16(bflo(qa[k]) * rs[ks][2 * k], bfhi(qa[k]) * rs[ks][2 * k + 1]); ob[k] = pg8::cvt_pk_bf16(bflo(qb[k]) * rs[ks][2 * k], bfhi(qb[k]) * rs[ks][2 * k + 1]); }
            xa[ks] = __builtin_bit_cast(bf16x8, oa); xb[ks] = __builtin_bit_cast(bf16x8, ob); }
        f32x4 accA[8], accB[8];
#pragma unroll
        for (int jt = 0; jt < 8; ++jt) { accA[jt] = (f32x4){0.f, 0.f, 0.f, 0.f}; accB[jt] = (f32x4){0.f, 0.f, 0.f, 0.f};
#pragma unroll
            for (int ks = 0; ks < 4; ++ks) if (32 * ks <= 16 * jt + 15) { const bf16x8 yf = *(const bf16x8*)(Wh + (16 * jt + fr) * 128 + ks * 32 + 8 * fq);
                accA[jt] = __builtin_amdgcn_mfma_f32_16x16x32_bf16(xa[ks], yf, accA[jt], 0, 0, 0); accB[jt] = __builtin_amdgcn_mfma_f32_16x16x32_bf16(xb[ks], yf, accB[jt], 0, 0, 0); } }
        const int c8 = cb + 8 * fq; const f32x4 ga = *(const f32x4*)(gain + c8), gb = *(const f32x4*)(gain + c8 + 4);
#pragma unroll
        for (int jt = 0; jt < 8; ++jt) { const size_t m = (size_t)(m0 + 16 * jt + fr); const v4u uu = __builtin_nontemporal_load((const v4u*)(U + m * SW + c8)); const float b = bias[jt];
            v4u o;
            o.x = pg8::cvt_pk_bf16(bflo(uu.x) * (accA[jt][0] * ga[0] + b), bfhi(uu.x) * (accA[jt][1] * ga[1] + b)); o.y = pg8::cvt_pk_bf16(bflo(uu.y) * (accA[jt][2] * ga[2] + b), bfhi(uu.y) * (accA[jt][3] * ga[3] + b));
            o.z = pg8::cvt_pk_bf16(bflo(uu.z) * (accB[jt][0] * gb[0] + b), bfhi(uu.z) * (accB[jt][1] * gb[1] + b)); o.w = pg8::cvt_pk_bf16(bflo(uu.w) * (accB[jt][2] * gb[2] + b), bfhi(uu.w) * (accB[jt][3] * gb[3] + b));
            *(v4u*)((char*)YZ + pg8::blk_byte((int)m, 1024 + c8, 2048)) = o; }
    }
}

#ifndef PG8_SP2
#define PG8_SP2 true
#endif
#ifndef PG8_ALIGN
#define PG8_ALIGN true
#endif

__global__ void __launch_bounds__(NWAVES * 64, 2) mk_fwd(Args args) {
    extern __shared__ __attribute__((aligned(16))) unsigned char lds[];
    Frame F;
    F.lds = (LAS unsigned char*)lds;
    F.MISC = (volatile LAS unsigned*)(F.lds + MISC_OFF);
    F.G = gridDim.x; { const int bx = blockIdx.x; F.vcu = (F.G % 8 == 0) ? (bx % 8) * (F.G / 8) + bx / 8 : bx; }
    unsigned char* ws = args.ws;
    F.ctl = (gu32*)(ws + WS_CTL);
    for (int u = threadIdx.x; u < (LDS_BYTES - LDSCTL_OFF) / 4; u += NWAVES * 64) ((LAS unsigned*)(F.lds + LDSCTL_OFF))[u] = 0u;
    __syncthreads();
    const int lo = args.ph_lo, hi = args.ph_hi;
    XcdBarrier bar; bar.bar = (unsigned*)(F.ctl + CW_BAR); bar.x = 0; bar.st = nullptr;
    if (hi - lo > 1) bar = xcd_barrier_post((unsigned*)(F.ctl + CW_BAR), F.MISC + 8);
#define IN(k) (lo <= (k) && (k) < hi)
#define SEAM_G(k) do { if (IN(k) && IN((k) + 1)) xcd_barrier(bar, false); } while (0)
#define SEAM_P(k) do { if (IN(k) && IN((k) + 1)) xcd_barrier(bar, lmode); } while (0)
#define SEAM_L(k) do { if (IN(k) && IN((k) + 1)) { if (lmode) quad_barrier(qcnt, (unsigned*)(F.ctl + CW_BAR) + XB_TMO); else xcd_barrier(bar, false); } } while (0)
    unsigned* qcnt = (unsigned*)(F.ctl + CW_QUAD);
    F.gx = (int)blockIdx.x & 7; F.gr = (int)blockIdx.x >> 3; F.grp = 0;
    bool lmode = false; int cid = (int)blockIdx.x;

    bf16* const Hb = (bf16*)(ws + WS_H); bf16* const Fb = (bf16*)(ws + WS_F); bf16* const ACT = (bf16*)(ws + WS_ACT);
    bf16* const XB = (bf16*)(ws + WS_XB);
    bf16* const Ub = (bf16*)(ws + WS_U); bf16* const VT = (bf16*)(ws + WS_VT);
    bf16* const SGA = (bf16*)(ws + WS_SGA); bf16* const SGB = (bf16*)(ws + WS_SGB); bf16* const YZ = (bf16*)(ws + WS_YZ); bf16* const MM = (bf16*)(ws + WS_MM);

    if (IN(0)) { p0_items<0>(F, args, 0); norm_phase<false, true>(F, args.in[0], nullptr, nullptr, nullptr, 0.f, args.in[1], Hb); }
    SEAM_G(0);
    if (hi - lo > 1) {
        const unsigned rk = F.MISC[10], uni = F.MISC[11];
        lmode = (__builtin_amdgcn_readfirstlane(uni) == 1u) && F.G == 256 && !MK_FORCE_GRID_BARRIERS;
        if (lmode) { F.gx = (int)bar.x; F.gr = (int)__builtin_amdgcn_readfirstlane(rk); cid = F.gr * 8 + F.gx; qcnt += 64 * (F.gx * 8 + (F.gr & 7)); }
    }
    F.grp = (F.G == 256);
    const int myslot = (lmode ? (F.gr & 7) : (cid & 7)) & 3;
#define CONV(q) do { if (l + 1 < NL && myslot == (q)) p0_items<1>(F, args, l + 1); } while (0)
    if (IN(1)) {
        const int fl = (int)blockIdx.x >> 5;
        if (fl < NL) {
            pg8::Gemm g{(const bf16*)(ws + WS_TPO + (size_t)fl * 4 * MiB), (const bf16*)(ws + WS_TGS + (size_t)fl * (MiB / 2)), D, PW, 256, PW, 256, 256}; g.base = (const char*)ws; pg8::StaticOrder S; S.init(D, PW, 32, (int)blockIdx.x & 31);
            pg8::EpiBf16S E{(bf16*)(ws + WS_W + (size_t)fl * LW_STRIDE + LW_WPS), 2048, nullptr, 1};
            pg8::gemm_phase<pg8::EpiBf16S, pg8::StaticOrder, PG8_ALIGN, PG8_SP2>(F.lds + RING_OFF, g, S, E);
        }
    }
    SEAM_G(1);
    if (lmode && STAGGER_US > 0) { const unsigned long long t0 = __builtin_amdgcn_s_memrealtime(), dt = (unsigned long long)(F.gx >> 1) * STAGGER_US * 100ull;
        while (__builtin_amdgcn_s_memrealtime() - t0 < dt) __builtin_amdgcn_s_sleep(8); }

    for (int s = 0; s < 2 * NL; ++s) {
        const int l = s >> 1, second = s & 1, pb = 2 + 11 * l + (second ? 8 : 0);
        unsigned char* wl = ws + WS_W + (size_t)l * LW_STRIDE;
        if (IN(pb)) {
            if (second) CONV(2);
            pg8::Gemm g{Hb, (const bf16*)(wl + (second ? LW_UP2 : LW_UP1)), M, NUP, D, D, D, 0}; g.base = (const char*)ws; pg8::StaticOrder S; S.init(M, NUP, F.G, cid);
            pg8::EpiSwiGLU E{ACT, FF};
            pg8::gemm_phase<pg8::EpiSwiGLU, pg8::StaticOrder, PG8_ALIGN, PG8_SP2>(F.lds + RING_OFF, g, S, E);
        }
        SEAM_L(pb);
        if (IN(pb + 1)) {
            if (second) CONV(3);
            pg8::Gemm g{ACT, (const bf16*)(wl + (second ? LW_DN2 : LW_DN1)), M, D, FF, FF, FF, 0}; g.base = (const char*)ws; pg8::StaticOrder S; S.init(M, D, F.G, cid);
            pg8::EpiBf16S E{Fb, D, nullptr, 0};
            pg8::gemm_phase<pg8::EpiBf16S, pg8::StaticOrder, PG8_ALIGN, PG8_SP2>(F.lds + RING_OFF, g, S, E);
        }
        SEAM_L(pb + 1);
        if (IN(pb + 2)) {
            const float* gpost = (second ? args.in[19] : args.in[4]) + (size_t)l * D;
            const float* gnext = second ? (l + 1 < NL ? args.in[1] + (size_t)(l + 1) * D : nullptr) : args.in[5] + (size_t)l * D;
            if (s == 0) norm_phase<false, true>(F, args.in[0], XB, Fb, gpost, 0.5f, gnext, Hb);
            else if (s == 2 * NL - 1) norm_phase<true, false>(F, XB, args.out, Fb, gpost, 0.5f, gnext, Hb);
            else norm_phase<true, true>(F, XB, XB, Fb, gpost, 0.5f, gnext, Hb);
        }
        if (second && l + 1 < NL) SEAM_G(pb + 2); else SEAM_L(pb + 2);
        if (!second) {
            if (IN(pb + 3)) {
                pg8::Gemm g{Hb, (const bf16*)(wl + LW_WIN), M, NIN, D, D, D, 0}; g.base = (const char*)ws; pg8::StaticOrder S; S.init(M, NIN, F.G, cid);
                pg8::EpiInProj E{(bf16*)(ws + ((l & 1) ? WS_P1 : WS_P)), Ub, VT, SGA, SGB, M, (float*)(ws + WS_SSQ)};
                pg8::gemm_phase<pg8::EpiInProj, pg8::StaticOrder, PG8_ALIGN, PG8_SP2>(F.lds + RING_OFF, g, S, E);
            }
            SEAM_P(pb + 3);
            if (IN(pb + 4)) {
                CONV(0);
                const int u0 = F.grp ? 32 * F.gx + 4 * (F.gr & 7) + (F.gr >> 3) : F.vcu;
                for (int u = u0; u < M / 64; u += F.G) pool_unit(F, (const bf16*)(ws + ((l & 1) ? WS_P1 : WS_P)), YZ, u);
                for (int u = u0; u < 2 * (M / 128); u += F.G)
                    sgu_unit(F, VT, Ub, YZ, (const float*)(ws + WS_SSQ), (const bf16*)(wl + LW_WG), args.in[12] + (size_t)l * 8 * 128, args.in[10] + (size_t)l * SW, u);
            }
            SEAM_L(pb + 4);
            if (IN(pb + 5)) {
                pg8::Gemm g{YZ, (const bf16*)(wl + LW_WPS), M, D, 2048, 2048, 2048, 0}; g.base = (const char*)ws; pg8::StaticOrder S; S.init(M, D, F.G, cid);
                pg8::EpiGate E{SGA, SGB, MM};
                pg8::gemm_phase<pg8::EpiGate, pg8::StaticOrder, PG8_ALIGN, PG8_SP2>(F.lds + RING_OFF, g, S, E);
            }
            SEAM_L(pb + 5);
            if (IN(pb + 6)) {
                CONV(1);
                pg8::Gemm g{MM, (const bf16*)(wl + LW_WO), M, D, D, D, D, 0}; g.base = (const char*)ws; pg8::StaticOrder S; S.init(M, D, F.G, cid);
                pg8::EpiBf16S E{Fb, D, nullptr, 0};
                pg8::gemm_phase<pg8::EpiBf16S, pg8::StaticOrder, PG8_ALIGN, PG8_SP2>(F.lds + RING_OFF, g, S, E);
            }
            SEAM_L(pb + 6);
            if (IN(pb + 7)) norm_phase<true, true>(F, XB, XB, Fb, args.in[15] + (size_t)l * D, 1.0f, args.in[16] + (size_t)l * D, Hb);
            SEAM_L(pb + 7);
        }
    }
#undef IN
#undef SEAM_G
#undef SEAM_P
#undef SEAM_L
#undef CONV
}

extern "C" void kernel_launch(void* const* d_in, const int* in_sizes, int n_in, void* d_out, int out_size, void* d_ws, size_t ws_size, hipStream_t stream) {
    static int grid = 0;
    if (grid == 0) {
        if (n_in != 20 || in_sizes[0] != M * D || out_size != M * D || ws_size < WS_END) { fprintf(stderr, "kernel_launch: shape/workspace mismatch: n_in %d in0 %d out %d ws %zu (need %zu)\n", n_in, n_in > 0 ? in_sizes[0] : -1, out_size, ws_size, (size_t)WS_END); grid = -1; return; }
        int dev = 0, cus = 0, per_cu = 0;
        if (hipGetDevice(&dev) != hipSuccess || hipDeviceGetAttribute(&cus, hipDeviceAttributeMultiprocessorCount, dev) != hipSuccess) { fprintf(stderr, "kernel_launch: device query failed\n"); grid = -1; return; }
        if (hipFuncSetAttribute((const void*)mk_fwd, hipFuncAttributeMaxDynamicSharedMemorySize, LDS_BYTES) != hipSuccess) { fprintf(stderr, "kernel_launch: hipFuncSetAttribute failed\n"); grid = -1; return; }
        if (hipOccupancyMaxActiveBlocksPerMultiprocessor(&per_cu, (const void*)mk_fwd, NWAVES * 64, LDS_BYTES) != hipSuccess || per_cu < 1) { fprintf(stderr, "kernel_launch: occupancy query reports %d workgroups per CU\n", per_cu); per_cu = 1; }
        (void)hipGetLastError();
        grid = cus;
    }
    if (grid < 0) return;
    if (hipMemsetAsync((char*)d_ws + WS_CTL, 0, CTL_ZERO_BYTES, stream) != hipSuccess) { fprintf(stderr, "kernel_launch: memset failed\n"); return; }
    Args a{};
    for (int i = 0; i < 20; ++i) a.in[i] = (const float*)d_in[i];
    a.out = (float*)d_out; a.ws = (unsigned char*)d_ws;
#if MK_ONE_LAUNCH
    a.ph_lo = 0; a.ph_hi = N_PHASES;
    hipLaunchKernelGGL(mk_fwd, dim3(grid), dim3(NWAVES * 64), LDS_BYTES, stream, a);
#else
    for (int p = 0; p < N_PHASES; ++p) { a.ph_lo = p; a.ph_hi = p + 1; hipLaunchKernelGGL(mk_fwd, dim3(grid), dim3(NWAVES * 64), LDS_BYTES, stream, a); }
#endif
    const hipError_t le = hipPeekAtLastError();
    if (le != hipSuccess) fprintf(stderr, "kernel_launch: launch failed: %s\n", hipGetErrorName(le));
}
```
